# Optimizing an MI355X kernel written in HIP

```python
import jax
import jax.numpy as jnp
from jax import lax
import numpy as np

D_MODEL = 2048
BATCH = 2
SEQ = 4096
DEPTH = 2
DEC_BATCH = 4
DEC_SEQ = 2048
PAST_LEN = 128

GRID_W = 64
PLE_DIM = 256
D_FF = 4 * D_MODEL
ROPE_THETA = 10000.0
EPS = 1e-6

MLA_HEADS = 8
MLA_NOPE = 128
MLA_ROPE = 64
MLA_QK = MLA_NOPE + MLA_ROPE
MLA_V = 128
Q_LORA = 512
KV_LORA = 256
MLA_QBLOCK = 128

NA_HEADS = 8
NA_HEAD_DIM = 128
NA_KH_MAX = 8
NA_KW = 16

SWA_HEADS = 16
SWA_KV_HEADS = 4
SWA_HEAD_DIM = 128
SWA_WINDOW = 128
SWA_BLOCK = 128

EVEN_IN = Q_LORA + KV_LORA + MLA_ROPE + 3 * NA_HEADS * NA_HEAD_DIM
EVEN_MIX = MLA_HEADS * MLA_V + NA_HEADS * NA_HEAD_DIM
ODD_IN = (SWA_HEADS + 2 * SWA_KV_HEADS) * SWA_HEAD_DIM
ODD_MIX = SWA_HEADS * SWA_HEAD_DIM
N_EVEN = (DEPTH + 1) // 2
N_ODD = DEPTH // 2

kernel_name = 'hybrid_mla_natten_swa_encoder'


def rms_norm(x, g):
    xf = x.astype(jnp.float32)
    y = xf * lax.rsqrt(jnp.mean(xf * xf, axis=-1, keepdims=True) + EPS)
    return (y * g.astype(jnp.float32)).astype(x.dtype)


def rope_tables(T, dim):
    inv_freq = 1.0 / (ROPE_THETA ** (jnp.arange(0, dim, 2, dtype=jnp.float32) / dim))
    ang = jnp.arange(T, dtype=jnp.float32)[:, None] * inv_freq[None, :]
    return jnp.cos(ang), jnp.sin(ang)


def apply_rope(x, cos, sin):
    half = x.shape[-1] // 2
    x1, x2 = x[..., :half], x[..., half:]
    c = cos[:, None, :].astype(x.dtype)
    s = sin[:, None, :].astype(x.dtype)
    return jnp.concatenate([x1 * c - x2 * s, x2 * c + x1 * s], axis=-1)


def mla_attention(q_lat, kv_lat, k_rope, q_a_norm, w_q_b, kv_a_norm, w_kv_b,
                  q_nope_norm, q_rope_norm, k_nope_norm, k_rope_norm):
    B, T, _ = q_lat.shape
    q = (rms_norm(q_lat, q_a_norm) @ w_q_b).reshape(B, T, MLA_HEADS, MLA_QK)
    kv = (rms_norm(kv_lat, kv_a_norm) @ w_kv_b).reshape(B, T, MLA_HEADS, MLA_NOPE + MLA_V)
    cos, sin = rope_tables(T, MLA_ROPE)
    q_nope = rms_norm(q[..., :MLA_NOPE], q_nope_norm)
    q_rope = apply_rope(rms_norm(q[..., MLA_NOPE:], q_rope_norm), cos, sin)
    k_nope = rms_norm(kv[..., :MLA_NOPE], k_nope_norm)
    v = kv[..., MLA_NOPE:]
    k_r = apply_rope(rms_norm(k_rope, k_rope_norm)[:, :, None, :], cos, sin)[:, :, 0, :]
    scale = MLA_QK ** -0.5
    nb = T // MLA_QBLOCK
    qn_blocks = q_nope.reshape(B, nb, MLA_QBLOCK, MLA_HEADS, MLA_NOPE).transpose(1, 0, 2, 3, 4)
    qr_blocks = q_rope.reshape(B, nb, MLA_QBLOCK, MLA_HEADS, MLA_ROPE).transpose(1, 0, 2, 3, 4)

    def attend_block(blk):
        qn, qr = blk
        s = jnp.einsum('bqhd,bkhd->bhqk', qn, k_nope) + jnp.einsum('bqhd,bkd->bhqk', qr, k_r)
        p = jax.nn.softmax(s.astype(jnp.float32) * scale, axis=-1).astype(v.dtype)
        return jnp.einsum('bhqk,bkhd->bqhd', p, v)

    o = lax.map(attend_block, (qn_blocks, qr_blocks))
    return o.transpose(1, 0, 2, 3, 4).reshape(B, T, MLA_HEADS * MLA_V)


def neighbourhood_attention(q, k, v, rpb):
    B, T, H, dh = q.shape
    rows = T // GRID_W
    kh = min(NA_KH_MAX, rows)
    col = jnp.arange(GRID_W)
    c_start = jnp.clip(col - NA_KW // 2, 0, GRID_W - NA_KW)
    kcol = c_start[:, None] + jnp.arange(NA_KW)[None, :]
    dc_idx = kcol - col[:, None] + (NA_KW - 1)
    scale = dh ** -0.5
    q_rows = q.reshape(B, rows, GRID_W, H, dh).transpose(1, 0, 2, 3, 4)

    def row_block(args):
        r, q_row = args
        r_start = jnp.clip(r - kh // 2, 0, rows - kh)
        krow = r_start + jnp.arange(kh)
        idx = krow[None, :, None] * GRID_W + kcol[:, None, :]
        kg = k[:, idx]
        vg = v[:, idx]
        dr_idx = krow - r + (NA_KH_MAX - 1)
        bias = rpb[:, dr_idx[None, :, None], dc_idx[:, None, :]]
        s = jnp.einsum('bwhd,bwijhd->bhwij', q_row, kg).astype(jnp.float32) * scale
        s = s + bias[None].astype(jnp.float32)
        p = jax.nn.softmax(s.reshape(B, H, GRID_W, kh * NA_KW), axis=-1)
        p = p.reshape(B, H, GRID_W, kh, NA_KW).astype(v.dtype)
        return jnp.einsum('bhwij,bwijhd->bwhd', p, vg)

    o = lax.map(row_block, (jnp.arange(rows), q_rows))
    return o.transpose(1, 0, 2, 3, 4).reshape(B, T, H * dh)


def sliding_window_attention(q, k, v, sinks):
    B, T, H, dh = q.shape
    hkv = k.shape[2]
    G = H // hkv
    nb = T // SWA_BLOCK
    qb = q.reshape(B, nb, SWA_BLOCK, hkv, G, dh)
    pad = ((0, 0), (SWA_BLOCK, SWA_BLOCK), (0, 0), (0, 0))
    kp = jnp.pad(k, pad).reshape(B, nb + 2, SWA_BLOCK, hkv, dh)
    vp = jnp.pad(v, pad).reshape(B, nb + 2, SWA_BLOCK, hkv, dh)
    kw = jnp.concatenate([kp[:, :-2], kp[:, 1:-1], kp[:, 2:]], axis=2)
    vw = jnp.concatenate([vp[:, :-2], vp[:, 1:-1], vp[:, 2:]], axis=2)
    qpos = jnp.arange(T).reshape(nb, SWA_BLOCK)
    kpos = (jnp.arange(nb)[:, None] - 1) * SWA_BLOCK + jnp.arange(3 * SWA_BLOCK)[None, :]
    mask = ((jnp.abs(qpos[:, :, None] - kpos[:, None, :]) <= SWA_WINDOW)
            & (kpos[:, None, :] >= 0) & (kpos[:, None, :] < T))
    scale = dh ** -0.5
    s = jnp.einsum('bnqkgd,bnskd->bnkgqs', qb, kw).astype(jnp.float32) * scale
    s = jnp.where(mask[None, :, None, None], s, -jnp.inf)
    sink = jnp.broadcast_to(sinks.astype(jnp.float32).reshape(hkv, G)[None, None, :, :, None, None],
                            s.shape[:-1] + (1,))
    p = jax.nn.softmax(jnp.concatenate([s, sink], axis=-1), axis=-1)[..., :-1]
    o = jnp.einsum('bnkgqs,bnskd->bnqkgd', p.astype(v.dtype), vw)
    return o.reshape(B, T, H * dh)


def even_mixer(h, w_in, q_a_norm, w_q_b, kv_a_norm, w_kv_b, q_nope_norm, q_rope_norm,
               k_nope_norm, k_rope_norm, na_q_norm, na_k_norm, na_rpb, w_out):
    B, T, _ = h.shape
    z = h @ w_in
    o1 = Q_LORA
    o2 = o1 + KV_LORA
    o3 = o2 + MLA_ROPE
    na_w = NA_HEADS * NA_HEAD_DIM
    o4 = o3 + na_w
    o5 = o4 + na_w
    mla_out = mla_attention(z[..., :o1], z[..., o1:o2], z[..., o2:o3], q_a_norm, w_q_b,
                            kv_a_norm, w_kv_b, q_nope_norm, q_rope_norm, k_nope_norm, k_rope_norm)
    nq = rms_norm(z[..., o3:o4].reshape(B, T, NA_HEADS, NA_HEAD_DIM), na_q_norm)
    nk = rms_norm(z[..., o4:o5].reshape(B, T, NA_HEADS, NA_HEAD_DIM), na_k_norm)
    nv = z[..., o5:].reshape(B, T, NA_HEADS, NA_HEAD_DIM)
    na_out = neighbourhood_attention(nq, nk, nv, na_rpb)
    return jnp.concatenate([mla_out, na_out], axis=-1) @ w_out


def odd_mixer(h, w_in, q_norm, k_norm, sinks, w_out):
    B, T, _ = h.shape
    z = h @ w_in
    nq = SWA_HEADS * SWA_HEAD_DIM
    nkv = SWA_KV_HEADS * SWA_HEAD_DIM
    q = rms_norm(z[..., :nq].reshape(B, T, SWA_HEADS, SWA_HEAD_DIM), q_norm)
    k = rms_norm(z[..., nq:nq + nkv].reshape(B, T, SWA_KV_HEADS, SWA_HEAD_DIM), k_norm)
    v = z[..., nq + nkv:].reshape(B, T, SWA_KV_HEADS, SWA_HEAD_DIM)
    cos, sin = rope_tables(T, SWA_HEAD_DIM)
    q = apply_rope(q, cos, sin)
    k = apply_rope(k, cos, sin)
    return sliding_window_attention(q, k, v, sinks) @ w_out


def squared_relu_mlp(h, w_up, w_down):
    a = jax.nn.relu(h @ w_up)
    return (a * a) @ w_down


def per_layer_embedding(x, p_i, w_gate, w_proj, g):
    return jax.nn.sigmoid(x @ w_gate) * rms_norm(p_i @ w_proj, g)


def setup_inputs(seed: int = 0) -> dict:
    key = jax.random.key(seed)
    ks = list(jax.random.split(key, 40))

    def nrm(shape, scale):
        return jax.random.normal(ks.pop(), shape, jnp.float32) * scale

    def gain(shape):
        return 1.0 + 0.1 * jax.random.normal(ks.pop(), shape, jnp.float32)

    D = D_MODEL
    return {
        'x_prompt': nrm((BATCH, SEQ, D), 1.0),
        'x_sample': nrm((DEC_BATCH, DEC_SEQ, D), 1.0),
        'p_prompt': nrm((DEPTH, BATCH, SEQ, PLE_DIM), 1.0),
        'p_sample': nrm((DEPTH, DEC_BATCH, DEC_SEQ, PLE_DIM), 1.0),
        'attn_norm': gain((DEPTH, D)),
        'mlp_norm': gain((DEPTH, D)),
        'w_up': nrm((DEPTH, D, D_FF), D ** -0.5),
        'w_down': nrm((DEPTH, D_FF, D), D_FF ** -0.5),
        'ple_gate': nrm((DEPTH, D, D), D ** -0.5),
        'ple_proj': nrm((DEPTH, PLE_DIM, D), PLE_DIM ** -0.5),
        'ple_norm': gain((DEPTH, D)),
        'ev_w_in': nrm((N_EVEN, D, EVEN_IN), D ** -0.5),
        'mla_q_a_norm': gain((N_EVEN, Q_LORA)),
        'mla_w_q_b': nrm((N_EVEN, Q_LORA, MLA_HEADS * MLA_QK), Q_LORA ** -0.5),
        'mla_kv_a_norm': gain((N_EVEN, KV_LORA)),
        'mla_w_kv_b': nrm((N_EVEN, KV_LORA, MLA_HEADS * (MLA_NOPE + MLA_V)), KV_LORA ** -0.5),
        'mla_q_nope_norm': gain((N_EVEN, MLA_NOPE)),
        'mla_q_rope_norm': gain((N_EVEN, MLA_ROPE)),
        'mla_k_nope_norm': gain((N_EVEN, MLA_NOPE)),
        'mla_k_rope_norm': gain((N_EVEN, MLA_ROPE)),
        'na_q_norm': gain((N_EVEN, NA_HEAD_DIM)),
        'na_k_norm': gain((N_EVEN, NA_HEAD_DIM)),
        'na_rpb': nrm((N_EVEN, NA_HEADS, 2 * NA_KH_MAX - 1, 2 * NA_KW - 1), 0.5),
        'ev_w_out': nrm((N_EVEN, EVEN_MIX, D), EVEN_MIX ** -0.5),
        'od_w_in': nrm((N_ODD, D, ODD_IN), D ** -0.5),
        'swa_q_norm': gain((N_ODD, SWA_HEAD_DIM)),
        'swa_k_norm': gain((N_ODD, SWA_HEAD_DIM)),
        'swa_sinks': nrm((N_ODD, SWA_HEADS), 1.0),
        'od_w_out': nrm((N_ODD, ODD_MIX, D), ODD_MIX ** -0.5),
    }


def reference(x_prompt, x_sample, p_prompt, p_sample, attn_norm, mlp_norm, w_up, w_down,
              ple_gate, ple_proj, ple_norm, ev_w_in, mla_q_a_norm, mla_w_q_b, mla_kv_a_norm,
              mla_w_kv_b, mla_q_nope_norm, mla_q_rope_norm, mla_k_nope_norm, mla_k_rope_norm,
              na_q_norm, na_k_norm, na_rpb, ev_w_out, od_w_in, swa_q_norm, swa_k_norm,
              swa_sinks, od_w_out):
    def run(x, p):
        for i in range(DEPTH):
            j = i // 2
            h = rms_norm(x, attn_norm[i])
            if i % 2 == 0:
                mix = even_mixer(h, ev_w_in[j], mla_q_a_norm[j], mla_w_q_b[j], mla_kv_a_norm[j],
                                 mla_w_kv_b[j], mla_q_nope_norm[j], mla_q_rope_norm[j],
                                 mla_k_nope_norm[j], mla_k_rope_norm[j], na_q_norm[j],
                                 na_k_norm[j], na_rpb[j], ev_w_out[j])
            else:
                mix = odd_mixer(h, od_w_in[j], swa_q_norm[j], swa_k_norm[j], swa_sinks[j],
                                od_w_out[j])
            x = x + mix
            x = x + squared_relu_mlp(rms_norm(x, mlp_norm[i]), w_up[i], w_down[i])
            x = x + per_layer_embedding(x, p[i], ple_gate[i], ple_proj[i], ple_norm[i])
        return x

    y_prompt = run(x_prompt, p_prompt)
    y_sample = run(x_sample, p_sample)
    return (y_prompt, y_sample)
```

```cpp
#include <hip/hip_runtime.h>
#include <hip/hip_cooperative_groups.h>
#include <cstdio>
namespace cg = cooperative_groups;

#define LAS __attribute__((address_space(3)))
typedef unsigned short bf16_t;
typedef short bf16x8 __attribute__((ext_vector_type(8)));
typedef float f32x4 __attribute__((ext_vector_type(4)));
typedef float f32x16 __attribute__((ext_vector_type(16)));
typedef unsigned u32x4 __attribute__((ext_vector_type(4)));
typedef unsigned u32x2 __attribute__((ext_vector_type(2)));
typedef short s16x4 __attribute__((ext_vector_type(4)));

constexpr int M = 16384, D = 2048, DFF = 8192;
constexpr int EV_IN = 3904, EV_INP = 4096, OD_IN = 3072;
constexpr float EPS = 1e-6f;
constexpr float LOG2E = 1.4426950408889634f;
constexpr int NTHREADS = 512, NWAVES = 8;
constexpr int LDS_BYTES = 136 * 1024;
#ifndef ONLY
#define ONLY 0xffffffff
#endif
#define PH(b) (((ONLY) >> (b)) & 1u)
#ifndef REP_CONV
#define REP_CONV 1
#endif
#ifndef REP_ATT
#define REP_ATT 1
#endif
#define REP_MLA 1
#define REP_NA 1
#define REP_SWA 1
#ifndef REP_PREP
#define REP_PREP 1
#endif

enum { I_XP = 0, I_XS, I_PP, I_PS, I_ATTN_NORM, I_MLP_NORM, I_WUP, I_WDOWN, I_PLE_GATE, I_PLE_PROJ, I_PLE_NORM, I_EV_WIN, I_QA_NORM, I_WQB, I_KVA_NORM,
       I_WKVB, I_QNOPE_NORM, I_QROPE_NORM, I_KNOPE_NORM, I_KROPE_NORM, I_NAQ_NORM, I_NAK_NORM, I_RPB, I_EV_WOUT, I_OD_WIN, I_SWAQ_NORM, I_SWAK_NORM, I_SINKS, I_OD_WOUT, N_IN };

struct Params { const float* in[N_IN]; float* out; unsigned char* ws; };
typedef const Params __attribute__((address_space(4)))* KP;
#define KARG(name) KP name = (KP)__builtin_amdgcn_kernarg_segment_ptr(); asm volatile("" : "+s"(name))

constexpr size_t MiB = 1024 * 1024;
constexpr size_t W_UP = 0, W_DOWN = 32 * MiB, W_GATE = 64 * MiB, W_PROJ = 72 * MiB, W_MIX = 73 * MiB;
constexpr size_t W_EVIN = W_MIX, W_QB = W_MIX + 16 * MiB, W_KVB = W_QB + 3 * MiB / 2, W_EVOUT = W_KVB + 1 * MiB;
constexpr size_t W_ODIN = W_MIX, W_ODOUT = W_MIX + 12 * MiB;
constexpr size_t WS_H = 100 * MiB, WS_E = 164 * MiB, WS_PB = 228 * MiB, WS_BIG = 236 * MiB, WS_MISC = 492 * MiB;
constexpr size_t WS_BAR = WS_MISC + 512 * 1024;
constexpr size_t WS_SS = WS_MISC;
constexpr size_t WS_ROPE64 = WS_MISC + 1 * MiB, WS_ROPE128 = WS_MISC + 2 * MiB, W_GATE1 = WS_MISC + 4 * MiB, WS_PB1 = WS_MISC + 12 * MiB, WS_END = WS_MISC + 20 * MiB;
constexpr size_t B_H2 = WS_BIG + 192 * MiB;
constexpr size_t B_Z = WS_BIG;
constexpr size_t B_Q1 = WS_BIG, B_KV1 = WS_BIG + 48 * MiB;
constexpr size_t B_NQ = WS_BIG + 128 * MiB, B_NK = WS_BIG + 160 * MiB, B_NVT = WS_BIG + 192 * MiB;
constexpr size_t B_QN = WS_BIG + 224 * MiB, B_KVN = WS_BIG + 240 * MiB, B_KR = WS_BIG + 248 * MiB;
constexpr size_t B_OCAT0 = WS_BIG;
constexpr size_t HE_QM = WS_H, HE_KM = WS_H + 48 * MiB, HE_VTM = WS_H + 96 * MiB;
constexpr size_t B_SQ = WS_BIG + 96 * MiB, B_SK = WS_BIG + 160 * MiB, B_SVT = WS_BIG + 176 * MiB, B_OCAT1 = WS_BIG + 192 * MiB;
constexpr size_t B_ACT = WS_BIG;

__device__ __forceinline__ unsigned cvt_pk_bf16(float lo, float hi) { unsigned r; asm volatile("v_cvt_pk_bf16_f32 %0, %1, %2" : "=v"(r) : "v"(lo), "v"(hi)); return r; }
__device__ __forceinline__ float bf2f(unsigned short b) { return __uint_as_float(((unsigned)b) << 16); }
__device__ __forceinline__ float bflo(unsigned w) { return __uint_as_float(w << 16); }
__device__ __forceinline__ float bfhi(unsigned w) { return __uint_as_float(w & 0xffff0000u); }
__device__ __forceinline__ unsigned short f2bf(float f) { return (unsigned short)(cvt_pk_bf16(f, 0.f) & 0xffffu); }
__device__ __forceinline__ float wave_sum(float v) {
#pragma unroll
    for (int o = 1; o < 64; o <<= 1) v += __shfl_xor(v, o);
    return v;
}
template <int W> __device__ __forceinline__ float group_sum(float v) {
#pragma unroll
    for (int o = 1; o < W; o <<= 1) v += __shfl_xor(v, o);
    return v;
}
__device__ __forceinline__ unsigned dpp_ror8(unsigned x) { return (unsigned)__builtin_amdgcn_update_dpp(0, (int)x, 0x128, 0xf, 0xf, false); }
__device__ __forceinline__ int tok_pos(int tok) { return tok < 8192 ? (tok & 4095) : (tok & 2047); }


#define XB_TMO      128
#define XB_XCNT(j)  (256  + 64 * (j))
#define XB_XSUB(j)  (1280 + 64 * (j))
#define XB_XGEN(j)  (2304 + 64 * (j))
#define XB_TOP      3328
#define XB_TOPGEN   3392
#define XCD_BAR_WORDS 3456
#define XB_SPIN_CAP (1u << 18)
__device__ __forceinline__ unsigned xb_ld(unsigned* p)              { return __hip_atomic_load(p, __ATOMIC_RELAXED, __HIP_MEMORY_SCOPE_AGENT); }
__device__ __forceinline__ unsigned xb_add(unsigned* p, unsigned v) { return __hip_atomic_fetch_add(p, v, __ATOMIC_RELAXED, __HIP_MEMORY_SCOPE_AGENT); }
__device__ __forceinline__ unsigned xb_xcc_id() { return (unsigned)__builtin_amdgcn_s_getreg((3 << 11) | 20) & 0xFu; }
#define XB_SPIN(cond, bar) do { unsigned _sp = 0; while (cond) { __builtin_amdgcn_s_sleep(1); \
    if ((++_sp & 255u) == 0u) { if (xb_ld(&(bar)[XB_TMO])) break; if (_sp > XB_SPIN_CAP) { atomicAdd(&(bar)[XB_TMO], 1u); break; } } } } while (0)
struct XcdBarrier { unsigned* bar; unsigned x; volatile LAS unsigned* st; };
__device__ __forceinline__ XcdBarrier xcd_barrier_post(unsigned* bar, volatile LAS unsigned* st) {
    XcdBarrier b; b.bar = bar; b.x = xb_xcc_id(); b.st = st;
    if (threadIdx.x == 0) (void)xb_add(&bar[XB_XCNT(b.x)], 1u);
    return b;
}
__device__ __forceinline__ void xcd_barrier_complete(unsigned* bar, unsigned x, unsigned& nloc, unsigned& nx) {
    const unsigned G = gridDim.x * gridDim.y * gridDim.z;
    unsigned sum, cnt, mine, sp = 0u;
    for (;;) {
        sum = 0u; cnt = 0u; mine = 0u;
#pragma unroll
        for (unsigned j = 0; j < 16; ++j) { const unsigned c = xb_ld(&bar[XB_XCNT(j)]); sum += c; cnt += (c > 0u) ? 1u : 0u; mine = (j == x) ? c : mine; }
        if (sum == G) break;
        __builtin_amdgcn_s_sleep(1);
        if ((++sp & 255u) == 0u) { if (xb_ld(&bar[XB_TMO])) break; if (sp > XB_SPIN_CAP) { atomicAdd(&bar[XB_TMO], 1u); break; } }
    }
    nloc = mine > 0u ? mine : 1u; nx = cnt > 0u ? cnt : 1u;
}
__device__ __forceinline__ void xcd_barrier(const XcdBarrier& b) {
    asm volatile("s_waitcnt vmcnt(0)" ::: "memory");
    __syncthreads();
    if (threadIdx.x == 0) {
        unsigned* bar = b.bar;
        __builtin_amdgcn_s_waitcnt(0);
        unsigned nloc = b.st[0], nx = b.st[1];
        if (nloc == 0u) { xcd_barrier_complete(bar, b.x, nloc, nx); b.st[0] = nloc; b.st[1] = nx; }
        const unsigned old = xb_add(&bar[XB_XSUB(b.x)], 1u);
        const unsigned gen = old / nloc;
        if (old + 1u == (gen + 1u) * nloc) {
            __builtin_amdgcn_fence(__ATOMIC_RELEASE, "agent");
            asm volatile("s_waitcnt vmcnt(0)" ::: "memory");
            const unsigned og = xb_add(&bar[XB_TOP], 1u);
            const unsigned tg = og / nx;
            if (og + 1u == (tg + 1u) * nx) xb_add(&bar[XB_TOPGEN], 1u);
            else XB_SPIN(xb_ld(&bar[XB_TOPGEN]) == tg, bar);
            __builtin_amdgcn_fence(__ATOMIC_ACQUIRE, "agent");
            xb_add(&bar[XB_XGEN(b.x)], 1u);
            asm volatile("s_waitcnt vmcnt(0)" ::: "memory");
        } else {
            XB_SPIN(xb_ld(&bar[XB_XGEN(b.x)]) == gen, bar);
            __builtin_amdgcn_fence(__ATOMIC_ACQUIRE, "agent");
            asm volatile("s_waitcnt vmcnt(0)" ::: "memory");
        }
    }
    __syncthreads();
}

namespace pg8 {
constexpr int BM = 256, BK = 64, HALF = 128, HTB = HALF * BK * 2, STAGE_BYTES = 8 * HTB, NXCD = 8, WGM = 8;
__device__ __forceinline__ int lds_byte(int r, int c) { const int st = (r >> 4) * 2 + (c >> 5), rr = r & 15, cc = c & 31, ob = rr * 64 + cc * 2; return st * 1024 + (ob ^ (((ob >> 9) & 1) << 5)); }
__device__ __forceinline__ void stage_rc(int b, int& R, int& C) { const int st = b / 1024, sb = b % 1024, swz = sb ^ (((sb >> 9) & 1) << 5); R = (st >> 1) * 16 + swz / 64; C = (st & 1) * 32 + (swz % 64) / 2; }
__device__ __forceinline__ int perm32(int rho) { const int n = rho >> 4, i = rho & 15; return 8 * (i >> 2) + 4 * n + (i & 3); }

struct Unit { int pm, pn; };
struct Gemm { const bf16_t* A; const bf16_t* Bt; int M, N, K; };
struct StaticOrder {
    int nM, nN, nwg, G, c, ioff, icnt;
    __device__ void init(int M_, int N_, int G_, int c_, int ioff_ = 0, int icnt_ = 1 << 20) { nM = M_ / BM; nN = N_ / BM; nwg = nM * nN; G = G_; c = c_; ioff = ioff_; icnt = icnt_; }
    __device__ bool next(int i, Unit& u) const {
        if (i >= icnt) return false;
        const long L = (long)(i + ioff) * G + c; if (L >= nwg) return false;
        int wgid = (int)L; { const int q = nwg / NXCD, r = nwg % NXCD, xcd = wgid % NXCD, off = wgid / NXCD; wgid = (xcd < r ? xcd * (q + 1) : r * (q + 1) + (xcd - r) * q) + off; }
        const int nig = WGM * nN, gid = wgid / nig, fm = gid * WGM, gsz = (nM - fm) < WGM ? (nM - fm) : WGM;
        u.pm = fm + ((wgid % nig) % gsz); u.pn = (wgid % nig) / gsz; return true;
    }
};

__device__ __forceinline__ void store_pair_lines(bf16_t* O, int ldc, int row, int fr, int col0, u32x4 wA, u32x4 wB) {
    const u32x4 sA = {dpp_ror8(wA.x), dpp_ror8(wA.y), dpp_ror8(wA.z), dpp_ror8(wA.w)}, sB = {dpp_ror8(wB.x), dpp_ror8(wB.y), dpp_ror8(wB.z), dpp_ror8(wB.w)};
    const bool lo = fr < 8;
    const u32x4 o1 = lo ? wA : sB, o2 = lo ? sA : wB;
    const int r1 = row - fr + (fr & 7), cb = col0 + (lo ? 0 : 8);
    *(u32x4*)(O + (size_t)r1 * ldc + cb) = o1;
    *(u32x4*)(O + (size_t)(r1 + 8) * ldc + cb) = o2;
}
__device__ __forceinline__ void load_pair_lines(const bf16_t* P, int ld, int row, int fr, int col0, u32x4& wA, u32x4& wB, int boff = 8) {
    const bool lo = fr < 8;
    const int r1 = row - fr + (fr & 7), cb = col0 + (lo ? 0 : boff);
    const u32x4 l1 = *(const u32x4*)(P + (size_t)r1 * ld + cb), l2 = *(const u32x4*)(P + (size_t)(r1 + 8) * ld + cb);
    const u32x4 s1 = {dpp_ror8(l1.x), dpp_ror8(l1.y), dpp_ror8(l1.z), dpp_ror8(l1.w)}, s2 = {dpp_ror8(l2.x), dpp_ror8(l2.y), dpp_ror8(l2.z), dpp_ror8(l2.w)};
    wA = lo ? l1 : s2; wB = lo ? s1 : l2;
}
template <int ACT  > struct EpiBf16 {
    static constexpr bool PERM = true, F32OUT = false;
    bf16_t* O; int ldc;
    const float* ssin;
    float* ssout;
    __device__ __forceinline__ void operator()(const f32x4 (&acc)[2][2][4][2], const Unit& u, int wr, int wc, int fr, int fq) const {
        const int row0 = u.pm * BM + wr * 64 + fr; const int col0 = u.pn * BM + wc * 64 + 16 * fq;
#pragma unroll
        for (int ai = 0; ai < 2; ++ai)
#pragma unroll
            for (int m = 0; m < 4; ++m) { const int row = row0 + ai * HALF + m * 16;
                const float rs = ssin ? __builtin_amdgcn_rsqf(ssin[row] * (1.f / D) + EPS) : 1.0f; float sq = 0.f; u32x4 w[2];
#pragma unroll
                for (int bj = 0; bj < 2; ++bj) { f32x4 v0 = acc[ai][bj][m][0] * rs, v1 = acc[ai][bj][m][1] * rs;
                    if (ACT == 1) {
#pragma unroll
                        for (int j = 0; j < 4; ++j) { const float a = fmaxf(v0[j], 0.f), b = fmaxf(v1[j], 0.f); v0[j] = a * a; v1[j] = b * b; } }
                    sq += (v0[0] * v0[0] + v0[1] * v0[1]) + (v0[2] * v0[2] + v0[3] * v0[3]) + (v1[0] * v1[0] + v1[1] * v1[1]) + (v1[2] * v1[2] + v1[3] * v1[3]);
                    w[bj].x = cvt_pk_bf16(v0[0], v0[1]); w[bj].y = cvt_pk_bf16(v0[2], v0[3]); w[bj].z = cvt_pk_bf16(v1[0], v1[1]); w[bj].w = cvt_pk_bf16(v1[2], v1[3]); }
                store_pair_lines(O, ldc, row, fr, col0, w[0], w[1]);
                if (ssout) { sq += __shfl_xor(sq, 16); sq += __shfl_xor(sq, 32); if (fq == 0) unsafeAtomicAdd(ssout + row, sq); } }
    }
};
struct EpiResid {
    static constexpr bool PERM = false, F32OUT = false;
    float* X; bf16_t* XB; float* ssout;
    const float* rsin;
    const float* src_p; const float* src_s;
    __device__ __forceinline__ void operator()(const f32x4 (&acc)[2][2][4][2], const Unit& u, int wr, int wc, int fr, int fq) const {
        const int row0 = u.pm * BM + wr * 64 + fr, col0 = u.pn * BM + wc * 32 + 4 * fq;
#pragma unroll
        for (int ai = 0; ai < 2; ++ai)
#pragma unroll
            for (int m = 0; m < 4; ++m) { const int row = row0 + ai * HALF + m * 16; const size_t off = (size_t)row * D + col0; float sq = 0.f;
                const float sc = rsin ? __builtin_amdgcn_rcpf(rsin[row] * (1.f / D) + EPS) : 1.0f;
                const float* rp = src_p ? (row < 8192 ? src_p + off : src_s + (off - (size_t)8192 * D)) : X + off;
#pragma unroll
                for (int bj = 0; bj < 2; ++bj)
#pragma unroll
                    for (int n = 0; n < 2; ++n) { const f32x4 o = *(const f32x4*)(rp + bj * HALF + n * 16) + acc[ai][bj][m][n] * sc; *(f32x4*)(X + off + bj * HALF + n * 16) = o;
                        sq += (o[0] * o[0] + o[1] * o[1]) + (o[2] * o[2] + o[3] * o[3]);
                        u32x2 w; w.x = cvt_pk_bf16(o[0], o[1]); w.y = cvt_pk_bf16(o[2], o[3]); *(u32x2*)(XB + off + bj * HALF + n * 16) = w; }
                if (ssout) { sq += __shfl_xor(sq, 16); sq += __shfl_xor(sq, 32); if (fq == 0) unsafeAtomicAdd(ssout + row, sq); } }
    }
};
struct EpiGate {
    static constexpr bool PERM = false, F32OUT = false;
    float* X; const bf16_t* E; const float* sse; const float* g; bf16_t* XB; float* ssout;
    __device__ __forceinline__ void operator()(const f32x4 (&acc)[2][2][4][2], const Unit& u, int wr, int wc, int fr, int fq) const {
        const int row0 = u.pm * BM + wr * 64 + fr, col0 = u.pn * BM + wc * 32 + 4 * fq;
        f32x4 gv[2][2];
#pragma unroll
        for (int bj = 0; bj < 2; ++bj)
#pragma unroll
            for (int n = 0; n < 2; ++n) gv[bj][n] = *(const f32x4*)(g + col0 + bj * HALF + n * 16);
#pragma unroll
        for (int ai = 0; ai < 2; ++ai)
#pragma unroll
            for (int m = 0; m < 4; ++m) { const int row = row0 + ai * HALF + m * 16; const size_t off = (size_t)row * D + col0; const float ri = __builtin_amdgcn_rsqf(sse[row] * (1.f / D) + EPS); float sq = 0.f;
#pragma unroll
                for (int bj = 0; bj < 2; ++bj)
#pragma unroll
                    for (int n = 0; n < 2; ++n) { float* p = X + off + bj * HALF + n * 16; const u32x2 ew = *(const u32x2*)(E + off + bj * HALF + n * 16);
                        const f32x4 a = acc[ai][bj][m][n]; const f32x4 gg = gv[bj][n]; f32x4 o = *(const f32x4*)p;
                        const float e0 = bflo(ew.x), e1 = bfhi(ew.x), e2 = bflo(ew.y), e3 = bfhi(ew.y);
                        o[0] += e0 * ri * gg[0] * __builtin_amdgcn_rcpf(1.f + __builtin_amdgcn_exp2f(-a[0] * LOG2E));
                        o[1] += e1 * ri * gg[1] * __builtin_amdgcn_rcpf(1.f + __builtin_amdgcn_exp2f(-a[1] * LOG2E));
                        o[2] += e2 * ri * gg[2] * __builtin_amdgcn_rcpf(1.f + __builtin_amdgcn_exp2f(-a[2] * LOG2E));
                        o[3] += e3 * ri * gg[3] * __builtin_amdgcn_rcpf(1.f + __builtin_amdgcn_exp2f(-a[3] * LOG2E));
                        *(f32x4*)p = o;
                        if (XB) { sq += (o[0] * o[0] + o[1] * o[1]) + (o[2] * o[2] + o[3] * o[3]);
                            u32x2 w; w.x = cvt_pk_bf16(o[0], o[1]); w.y = cvt_pk_bf16(o[2], o[3]); *(u32x2*)(XB + off + bj * HALF + n * 16) = w; } }
                if (XB) { sq += __shfl_xor(sq, 16); sq += __shfl_xor(sq, 32); if (fq == 0) unsafeAtomicAdd(ssout + row, sq); } }
    }
};

struct EpiResidB {
    static constexpr bool PERM = true, F32OUT = false;
    const bf16_t* R;
    const float* src_p; const float* src_s;
    bf16_t* O;
    float* ssout;
    const float* rsin;
    __device__ __forceinline__ void operator()(const f32x4 (&acc)[2][2][4][2], const Unit& u, int wr, int wc, int fr, int fq) const {
        const int row0 = u.pm * BM + wr * 64 + fr, col0 = u.pn * BM + wc * 64 + 16 * fq;
#pragma unroll
        for (int ai = 0; ai < 2; ++ai)
#pragma unroll
            for (int m = 0; m < 4; ++m) { const int row = row0 + ai * HALF + m * 16; const size_t off = (size_t)row * D + col0; float sq = 0.f; u32x4 w[2];
                const float sc = rsin ? __builtin_amdgcn_rcpf(rsin[row] * (1.f / D) + EPS) : 1.0f;
                u32x4 rr[2]; if (R) load_pair_lines(R, D, row, fr, col0, rr[0], rr[1]);
#pragma unroll
                for (int bj = 0; bj < 2; ++bj) { f32x4 r0, r1;
                    if (R) { const u32x4 rw = rr[bj]; r0 = (f32x4){bflo(rw.x), bfhi(rw.x), bflo(rw.y), bfhi(rw.y)}; r1 = (f32x4){bflo(rw.z), bfhi(rw.z), bflo(rw.w), bfhi(rw.w)}; }
                    else { const float* rp = (row < 8192 ? src_p + off : src_s + (off - (size_t)8192 * D)) + 8 * bj; r0 = *(const f32x4*)rp; r1 = *(const f32x4*)(rp + 4); }
                    const f32x4 o0 = r0 + acc[ai][bj][m][0] * sc, o1 = r1 + acc[ai][bj][m][1] * sc;
                    sq += (o0[0] * o0[0] + o0[1] * o0[1]) + (o0[2] * o0[2] + o0[3] * o0[3]) + (o1[0] * o1[0] + o1[1] * o1[1]) + (o1[2] * o1[2] + o1[3] * o1[3]);
                    w[bj].x = cvt_pk_bf16(o0[0], o0[1]); w[bj].y = cvt_pk_bf16(o0[2], o0[3]); w[bj].z = cvt_pk_bf16(o1[0], o1[1]); w[bj].w = cvt_pk_bf16(o1[2], o1[3]); }
                store_pair_lines(O, D, row, fr, col0, w[0], w[1]);
                if (ssout) { sq += __shfl_xor(sq, 16); sq += __shfl_xor(sq, 32); if (fq == 0) unsafeAtomicAdd(ssout + row, sq); } }
    }
};
struct EpiGateB {
    static constexpr bool PERM = true, F32OUT = false;
    const bf16_t* R; const bf16_t* E; const float* sse; const float* g; bf16_t* O; float* ssout; float* OUT;
    __device__ __forceinline__ void operator()(const f32x4 (&acc)[2][2][4][2], const Unit& u, int wr, int wc, int fr, int fq) const {
        const int row0 = u.pm * BM + wr * 64 + fr, col0 = u.pn * BM + wc * 64 + 16 * fq;
        f32x4 gv[2][2];
#pragma unroll
        for (int bj = 0; bj < 2; ++bj) { gv[bj][0] = *(const f32x4*)(g + col0 + 8 * bj); gv[bj][1] = *(const f32x4*)(g + col0 + 8 * bj + 4); }
#pragma unroll
        for (int ai = 0; ai < 2; ++ai)
#pragma unroll
            for (int m = 0; m < 4; ++m) { const int row = row0 + ai * HALF + m * 16; const size_t off = (size_t)row * D + col0; const float ri = __builtin_amdgcn_rsqf(sse[row] * (1.f / D) + EPS); float sq = 0.f; u32x4 w[2];
                u32x4 rr[2], ee[2]; load_pair_lines(R, D, row, fr, col0, rr[0], rr[1]); load_pair_lines(E, D, row, fr, col0, ee[0], ee[1]);
#pragma unroll
                for (int bj = 0; bj < 2; ++bj) { const u32x4 rw = rr[bj], ew = ee[bj];
                    const float r[8] = {bflo(rw.x), bfhi(rw.x), bflo(rw.y), bfhi(rw.y), bflo(rw.z), bfhi(rw.z), bflo(rw.w), bfhi(rw.w)};
                    const float e[8] = {bflo(ew.x), bfhi(ew.x), bflo(ew.y), bfhi(ew.y), bflo(ew.z), bfhi(ew.z), bflo(ew.w), bfhi(ew.w)};
                    float o[8];
#pragma unroll
                    for (int j = 0; j < 8; ++j) { const float a = acc[ai][bj][m][j >> 2][j & 3]; const float gg = gv[bj][j >> 2][j & 3];
                        o[j] = r[j] + e[j] * ri * gg * __builtin_amdgcn_rcpf(1.f + __builtin_amdgcn_exp2f(-a * LOG2E)); }
                    if (OUT) { *(f32x4*)(OUT + off + 8 * bj) = (f32x4){o[0], o[1], o[2], o[3]}; *(f32x4*)(OUT + off + 8 * bj + 4) = (f32x4){o[4], o[5], o[6], o[7]}; }
                    else { sq += (o[0] * o[0] + o[1] * o[1]) + (o[2] * o[2] + o[3] * o[3]) + (o[4] * o[4] + o[5] * o[5]) + (o[6] * o[6] + o[7] * o[7]);
                        w[bj].x = cvt_pk_bf16(o[0], o[1]); w[bj].y = cvt_pk_bf16(o[2], o[3]); w[bj].z = cvt_pk_bf16(o[4], o[5]); w[bj].w = cvt_pk_bf16(o[6], o[7]); } }
                if (!OUT) { store_pair_lines(O, D, row, fr, col0, w[0], w[1]);
                    sq += __shfl_xor(sq, 16); sq += __shfl_xor(sq, 32); if (fq == 0) unsafeAtomicAdd(ssout + row, sq); } }
    }
};

struct EpiGateF32 {
    static constexpr bool PERM = true, F32OUT = true;
    const bf16_t* R; const bf16_t* E; const float* sse; const float* g; float* OUT;
    __device__ __forceinline__ void operator()(const f32x4 (&acc)[2][2][4][2], const Unit& u, int wr, int wc, int fr, int fq) const {
        const int row0 = u.pm * BM + wr * 64 + fr, col0 = u.pn * BM + wc * 64 + 8 * fq;
        f32x4 gv[2][2];
#pragma unroll
        for (int bj = 0; bj < 2; ++bj) { gv[bj][0] = *(const f32x4*)(g + col0 + 32 * bj); gv[bj][1] = *(const f32x4*)(g + col0 + 32 * bj + 4); }
        const bool lo = fr < 8;
#pragma unroll
        for (int ai = 0; ai < 2; ++ai)
#pragma unroll
            for (int m = 0; m < 4; ++m) { const int row = row0 + ai * HALF + m * 16; const float ri = __builtin_amdgcn_rsqf(sse[row] * (1.f / D) + EPS);
                u32x4 rr[2], ee[2]; load_pair_lines(R, D, row, fr, col0, rr[0], rr[1], 32); load_pair_lines(E, D, row, fr, col0, ee[0], ee[1], 32);
                float* orow = OUT + (size_t)(row - fr + (fr & 7)) * D + col0 + (lo ? 0 : 4);
#pragma unroll
                for (int bj = 0; bj < 2; ++bj) { const u32x4 rw = rr[bj], ew = ee[bj];
                    const float r[8] = {bflo(rw.x), bfhi(rw.x), bflo(rw.y), bfhi(rw.y), bflo(rw.z), bfhi(rw.z), bflo(rw.w), bfhi(rw.w)};
                    const float e[8] = {bflo(ew.x), bfhi(ew.x), bflo(ew.y), bfhi(ew.y), bflo(ew.z), bfhi(ew.z), bflo(ew.w), bfhi(ew.w)};
                    float o[8];
#pragma unroll
                    for (int j = 0; j < 8; ++j) { const float a = acc[ai][bj][m][j >> 2][j & 3]; const float gg = gv[bj][j >> 2][j & 3];
                        o[j] = r[j] + e[j] * ri * gg * __builtin_amdgcn_rcpf(1.f + __builtin_amdgcn_exp2f(-a * LOG2E)); }
                    f32x4 o1, o2;
#pragma unroll
                    for (int j = 0; j < 4; ++j) { const unsigned a = __float_as_uint(o[j]), b = __float_as_uint(o[4 + j]); const unsigned sa = dpp_ror8(a), sb = dpp_ror8(b);
                        o1[j] = __uint_as_float(lo ? a : sb); o2[j] = __uint_as_float(lo ? sa : b); }
                    *(f32x4*)(orow + 32 * bj) = o1; *(f32x4*)(orow + (size_t)8 * D + 32 * bj) = o2; } }
    }
};

template <class Epi>
__device__ __forceinline__ void gemm_phase(LAS unsigned char* lds, const Gemm g, const StaticOrder& S, const Epi& E) {
    int tid = threadIdx.x; asm volatile("" : "+v"(tid));
    const int wid = __builtin_amdgcn_readfirstlane(tid >> 6), lane = tid & 63, wr = wid >> 2, wc = wid & 3, fr = lane & 15, fq = lane >> 4;
    const int K = g.K, nt = K / BK;
    unsigned voffA[2], voffB0[2], voffB1[2];
#pragma unroll
    for (int i = 0; i < 2; ++i) { int R, C; stage_rc(tid * 16 + i * 8192, R, C);
        const int Rw = 64 * (R >> 5) + 16 * ((R >> 2) & 3) + 4 * ((R >> 4) & 1) + (R & 3);
        const int Rf = 64 * (R >> 5) + 8 * ((R >> 2) & 3) + 4 * ((R >> 4) & 1) + (R & 3);
        const int Rb0 = Epi::PERM ? (Epi::F32OUT ? Rf : Rw) : R, Rb1 = Epi::PERM ? (Epi::F32OUT ? Rf + 32 : Rw + 8) : R + HALF;
        voffA[i] = (unsigned)(R * K + C) * 2u; voffB0[i] = (unsigned)(Rb0 * K + C) * 2u; voffB1[i] = (unsigned)(Rb1 * K + C) * 2u; }
    const size_t kstep = (size_t)(BK * 2);
    const size_t hstep = (size_t)HALF * K * 2;
    const size_t tstep = 2 * hstep;
    const unsigned ldsw = (unsigned)wid * 1024u;
    const int aoff = lds_byte(wr * 64 + fr, fq * 8), boff = lds_byte(wc * 32 + fr, fq * 8);
#define PG8_SA(b, h) (((b) * 2 + (h)) * HTB)
#define PG8_SB(b, h) ((4 + (b) * 2 + (h)) * HTB)
#define PG8_STAGE(bufoff, gbase, voff) do { _Pragma("unroll") for (int _i = 0; _i < 2; ++_i) \
        __builtin_amdgcn_global_load_lds((const unsigned*)((const char*)(gbase) + (voff)[_i]), (LAS unsigned*)(lds + (bufoff) + ldsw + _i * 8192), 16, 0, 0); } while (0)
#define PG8_LDA(dst, b, h) do { _Pragma("unroll") for (int m = 0; m < 4; ++m) _Pragma("unroll") for (int k = 0; k < 2; ++k) dst[m][k] = *(const LAS bf16x8*)(lds + PG8_SA(b, h) + aoff + m * 2048 + k * 1024); } while (0)
#define PG8_LDB(dst, b, h) do { _Pragma("unroll") for (int n = 0; n < 2; ++n) _Pragma("unroll") for (int k = 0; k < 2; ++k) dst[n][k] = *(const LAS bf16x8*)(lds + PG8_SB(b, h) + boff + n * 2048 + k * 1024); } while (0)
#define PG8_MMA(ai, bj, At, Bt) do { __builtin_amdgcn_s_setprio(1); _Pragma("unroll") for (int m = 0; m < 4; ++m) _Pragma("unroll") for (int n = 0; n < 2; ++n) _Pragma("unroll") for (int k = 0; k < 2; ++k) \
        acc[ai][bj][m][n] = __builtin_amdgcn_mfma_f32_16x16x32_bf16(Bt[n][k], At[m][k], acc[ai][bj][m][n], 0, 0, 0); __builtin_amdgcn_s_setprio(0); } while (0)
#define PG8_WAIT_V(n) asm volatile("s_waitcnt vmcnt(" #n ")" ::: "memory")
#define PG8_WAIT_L(n) asm volatile("s_waitcnt lgkmcnt(" #n ")" ::: "memory")
#define PG8_BAR __builtin_amdgcn_s_barrier()
#define PG8_SCHED __builtin_amdgcn_sched_barrier(0)
    Unit cur, nxt; int ui = 0;
    if (!S.next(0, cur)) return;
    f32x4 acc[2][2][4][2];
#pragma unroll
    for (int a = 0; a < 2; ++a)
#pragma unroll
        for (int b = 0; b < 2; ++b)
#pragma unroll
            for (int m = 0; m < 4; ++m)
#pragma unroll
                for (int n = 0; n < 2; ++n) acc[a][b][m][n] = (f32x4){0.f, 0.f, 0.f, 0.f};
    bf16x8 At[4][2], B0[2][2], B1[2][2];
    const char* cA = (const char*)g.A + (size_t)cur.pm * tstep; const char* cB = (const char*)g.Bt + (size_t)cur.pn * tstep;
    PG8_STAGE(PG8_SB(0, 0), cB, voffB0); PG8_STAGE(PG8_SA(0, 0), cA, voffA); PG8_STAGE(PG8_SB(0, 1), cB, voffB1); PG8_STAGE(PG8_SA(0, 1), cA + hstep, voffA);
    if (wr == 1) PG8_BAR;
    PG8_WAIT_V(4); PG8_BAR;
    PG8_STAGE(PG8_SB(1, 0), cB + kstep, voffB0); PG8_STAGE(PG8_SA(1, 0), cA + kstep, voffA); PG8_STAGE(PG8_SB(1, 1), cB + kstep, voffB1);
    PG8_WAIT_V(6); PG8_BAR;
    for (;;) {
        const bool has_next = S.next(ui + 1, nxt);
        const char* nA = has_next ? (const char*)g.A + (size_t)nxt.pm * tstep : cA; const char* nB = has_next ? (const char*)g.Bt + (size_t)nxt.pn * tstep : cB;
        for (int t = 0; t < nt; t += 2) {
            const bool last = (t == nt - 2);
            const char* a1 = cA + (size_t)(t + 1) * kstep;
            const char* a2 = last ? nA : cA + (size_t)(t + 2) * kstep; const char* b2 = last ? nB : cB + (size_t)(t + 2) * kstep;
            const char* a3 = a2 + kstep; const char* b3 = b2 + kstep;
            PG8_LDB(B0, 0, 0); PG8_SCHED; PG8_LDA(At, 0, 0); PG8_STAGE(PG8_SA(1, 1), a1 + hstep, voffA);
            PG8_WAIT_L(8); PG8_BAR; PG8_WAIT_L(0); PG8_MMA(0, 0, At, B0); PG8_BAR; PG8_SCHED;
            PG8_LDB(B1, 0, 1); PG8_STAGE(PG8_SB(0, 0), b2, voffB0);
            PG8_BAR; PG8_WAIT_L(0); PG8_MMA(0, 1, At, B1); PG8_BAR;
            PG8_LDA(At, 0, 1); PG8_STAGE(PG8_SA(0, 0), a2, voffA);
            PG8_BAR; PG8_WAIT_L(0); PG8_MMA(1, 0, At, B0); PG8_BAR; PG8_SCHED;
            PG8_STAGE(PG8_SB(0, 1), b2, voffB1);
            PG8_WAIT_V(6); PG8_BAR; PG8_MMA(1, 1, At, B1); PG8_BAR;
            PG8_LDB(B0, 1, 0); PG8_SCHED; PG8_LDA(At, 1, 0); PG8_STAGE(PG8_SA(0, 1), a2 + hstep, voffA);
            PG8_WAIT_L(8); PG8_BAR; PG8_WAIT_L(0); PG8_MMA(0, 0, At, B0); PG8_BAR; PG8_SCHED;
            PG8_LDB(B1, 1, 1); PG8_STAGE(PG8_SB(1, 0), b3, voffB0);
            PG8_BAR; PG8_WAIT_L(0); PG8_MMA(0, 1, At, B1); PG8_BAR;
            PG8_LDA(At, 1, 1); PG8_STAGE(PG8_SA(1, 0), a3, voffA);
            PG8_BAR; PG8_WAIT_L(0); PG8_MMA(1, 0, At, B0); PG8_BAR; PG8_SCHED;
            PG8_STAGE(PG8_SB(1, 1), b3, voffB1);
            PG8_WAIT_V(6); PG8_BAR; PG8_MMA(1, 1, At, B1); PG8_BAR;
        }
        E(acc, cur, wr, wc, fr, fq);
        if (!has_next) break;
#pragma unroll
        for (int a = 0; a < 2; ++a)
#pragma unroll
            for (int b = 0; b < 2; ++b)
#pragma unroll
                for (int m = 0; m < 4; ++m)
#pragma unroll
                    for (int n = 0; n < 2; ++n) acc[a][b][m][n] = (f32x4){0.f, 0.f, 0.f, 0.f};
        cur = nxt; cA = nA; cB = nB; ++ui;
    }
    PG8_WAIT_V(0);
    if (wr == 0) PG8_BAR;
    PG8_BAR;
#undef PG8_SA
#undef PG8_SB
#undef PG8_STAGE
#undef PG8_LDA
#undef PG8_LDB
#undef PG8_MMA
#undef PG8_WAIT_V
#undef PG8_WAIT_L
#undef PG8_BAR
#undef PG8_SCHED
}
template <class Epi>
__device__ __forceinline__ void run_gemm(LAS unsigned char* lds, const bf16_t* A, const bf16_t* Bt, int N, int K, const Epi& E, int ioff = 0, int icnt = 1 << 20) {
    Gemm g{A, Bt, M, N, K}; StaticOrder S; S.init(M, N, (int)gridDim.x, (int)blockIdx.x, ioff, icnt);
    gemm_phase<Epi>(lds, g, S, E);
    __syncthreads();
}
}

__device__ __forceinline__ void transpose_item(const float* W, int K, int N, bf16_t* WT, LAS float* scr, int item, int lane, const float* gk) {
    const int nblk = N / 64, kb = item / nblk, nb = item % nblk, k0 = 64 * kb, n0 = 64 * nb;
    LAS unsigned char* tb = (LAS unsigned char*)scr;
    f32x4 v[16];
#pragma unroll
    for (int i = 0; i < 16; ++i) { const int kk = 4 * i + (lane >> 4); v[i] = *(const f32x4*)(W + (size_t)(k0 + kk) * N + n0 + 4 * (lane & 15)); }
    if (gk) {
#pragma unroll
        for (int i = 0; i < 16; ++i) v[i] *= gk[k0 + 4 * i + (lane >> 4)]; }
#pragma unroll
    for (int i = 0; i < 16; ++i) { u32x2 w; w.x = cvt_pk_bf16(v[i][0], v[i][1]); w.y = cvt_pk_bf16(v[i][2], v[i][3]);
        *(LAS u32x2*)(tb + (4 * i + (lane >> 4)) * 144 + 8 * (lane & 15)) = w; }
    asm volatile("s_waitcnt lgkmcnt(0)" ::: "memory");
    const int g = lane >> 4, i16 = lane & 15;
    const int rd_off = (i16 >> 2) * 144 + 8 * (i16 & 3);
#pragma unroll
    for (int nbk = 0; nbk < 4; ++nbk) {
        const LAS unsigned char* a1 = tb + (8 * g) * 144 + 32 * nbk + rd_off;
        const s16x4 qa1 = __builtin_amdgcn_ds_read_tr16_b64_v4i16((LAS s16x4*)a1), qa2 = __builtin_amdgcn_ds_read_tr16_b64_v4i16((LAS s16x4*)(a1 + 4 * 144));
        const s16x4 qb1 = __builtin_amdgcn_ds_read_tr16_b64_v4i16((LAS s16x4*)(a1 + 32 * 144)), qb2 = __builtin_amdgcn_ds_read_tr16_b64_v4i16((LAS s16x4*)(a1 + 36 * 144));
        const bf16x8 pa = {qa1[0], qa1[1], qa1[2], qa1[3], qa2[0], qa2[1], qa2[2], qa2[3]}, pb = {qb1[0], qb1[1], qb1[2], qb1[3], qb2[0], qb2[1], qb2[2], qb2[3]};
        const u32x4 wA = *(const u32x4*)&pa, wB = *(const u32x4*)&pb;
        const u32x4 sA = {dpp_ror8(wA.x), dpp_ror8(wA.y), dpp_ror8(wA.z), dpp_ror8(wA.w)}, sB = {dpp_ror8(wB.x), dpp_ror8(wB.y), dpp_ror8(wB.z), dpp_ror8(wB.w)};
        const bool lo = i16 < 8;
        const u32x4 o1 = lo ? wA : sB, o2 = lo ? sA : wB;
        bf16_t* dst = WT + (size_t)(n0 + 16 * nbk + (i16 & 7)) * K + k0 + 8 * (g + (lo ? 0 : 4));
        *(u32x4*)dst = o1; *(u32x4*)(dst + (size_t)8 * K) = o2; }
    asm volatile("s_waitcnt lgkmcnt(0)" ::: "memory");
}
__device__ __forceinline__ void convert_matrix(const float* W, int K, int N, bf16_t* WT, LAS float* scr, int gw, int ngw, int lane, const float* gk = nullptr) {
    const int nitems = (K / 64) * (N / 64);
    for (int it = gw; it < nitems; it += ngw) transpose_item(W, K, N, WT, scr, it, lane, gk);
}

__device__ __forceinline__ void norm_row(const float* xrow, const float* g, bf16_t* orow, float* xcopy, int lane) {
    f32x4 v[8]; float s = 0.f;
#pragma unroll
    for (int j = 0; j < 4; ++j) { v[2 * j] = ((const f32x4*)xrow)[2 * (lane + 64 * j)]; v[2 * j + 1] = ((const f32x4*)xrow)[2 * (lane + 64 * j) + 1]; }
#pragma unroll
    for (int j = 0; j < 8; ++j) s += (v[j][0] * v[j][0] + v[j][1] * v[j][1]) + (v[j][2] * v[j][2] + v[j][3] * v[j][3]);
    if (xcopy) {
#pragma unroll
        for (int j = 0; j < 4; ++j) { ((f32x4*)xcopy)[2 * (lane + 64 * j)] = v[2 * j]; ((f32x4*)xcopy)[2 * (lane + 64 * j) + 1] = v[2 * j + 1]; } }
    const float rinv = 1.0f / sqrtf(wave_sum(s) * (1.f / D) + EPS);
#pragma unroll
    for (int j = 0; j < 4; ++j) { const f32x4 g0 = ((const f32x4*)g)[2 * (lane + 64 * j)], g1 = ((const f32x4*)g)[2 * (lane + 64 * j) + 1]; const f32x4 a = v[2 * j], c = v[2 * j + 1];
        u32x4 w; w.x = cvt_pk_bf16(a[0] * rinv * g0[0], a[1] * rinv * g0[1]); w.y = cvt_pk_bf16(a[2] * rinv * g0[2], a[3] * rinv * g0[3]);
        w.z = cvt_pk_bf16(c[0] * rinv * g1[0], c[1] * rinv * g1[1]); w.w = cvt_pk_bf16(c[2] * rinv * g1[2], c[3] * rinv * g1[3]);
        ((u32x4*)orow)[lane + 64 * j] = w; }
}
__device__ __forceinline__ float rinv_row_bf16(const bf16_t* erow, int lane) {
    float s = 0.f;
#pragma unroll
    for (int j = 0; j < 4; ++j) { const u32x4 w = ((const u32x4*)erow)[lane + 64 * j];
        const float a0 = bflo(w.x), a1 = bfhi(w.x), a2 = bflo(w.y), a3 = bfhi(w.y), a4 = bflo(w.z), a5 = bfhi(w.z), a6 = bflo(w.w), a7 = bfhi(w.w);
        s += (a0 * a0 + a1 * a1) + (a2 * a2 + a3 * a3) + (a4 * a4 + a5 * a5) + (a6 * a6 + a7 * a7); }
    return 1.0f / sqrtf(wave_sum(s) * (1.f / D) + EPS);
}
__device__ __forceinline__ void conv_p_row(const float* prow, bf16_t* orow, int lane) {
    const f32x4 v = ((const f32x4*)prow)[lane]; u32x2 w; w.x = cvt_pk_bf16(v[0], v[1]); w.y = cvt_pk_bf16(v[2], v[3]); ((u32x2*)orow)[lane] = w;
}

__device__ __forceinline__ void vt_item(LAS unsigned char* lds, const bf16_t* src, int sstride, bf16_t* vt_rows, int tok0) {
    int tid = threadIdx.x; asm volatile("" : "+v"(tid));
    constexpr int TROW = 272;
#pragma unroll
    for (int i = 0; i < 2; ++i) { const int cid = tid + i * 512, row = cid >> 4, cc = cid & 15;
        const u32x4 v = *(const u32x4*)(src + (size_t)row * sstride + cc * 8);
        *(LAS u32x4*)(lds + row * TROW + cc * 16) = v; }
    __syncthreads();
#pragma unroll
    for (int i = 0; i < 2; ++i) { const int wid2 = tid + i * 512, d = wid2 >> 3, ck = wid2 & 7;
        unsigned short e[8];
#pragma unroll
        for (int j = 0; j < 8; ++j) { const int quad = (ck & 1) * 2 + (j >> 2); const int q2 = (quad == 1) ? 2 : (quad == 2 ? 1 : quad); const int t = (ck >> 1) * 16 + q2 * 4 + (j & 3);
            e[j] = *(const LAS unsigned short*)(lds + t * TROW + d * 2); }
        u32x4 o; o.x = e[0] | ((unsigned)e[1] << 16); o.y = e[2] | ((unsigned)e[3] << 16); o.z = e[4] | ((unsigned)e[5] << 16); o.w = e[6] | ((unsigned)e[7] << 16);
        *(u32x4*)(vt_rows + (size_t)d * M + tok0 + ck * 8) = o; }
    __syncthreads();
}

__device__ __forceinline__ int crow(int r, int hi) { return (r & 3) + 8 * (r >> 2) + 4 * hi; }
template <int DQK> struct AG { static constexpr int KROW = DQK * 2 + 16, KBUF = 64 * KROW, VROW = 144, VBUF = 128 * VROW, VOFF = 2 * KBUF, KC = (64 * DQK / 8) / 512, RPB_OFF = 2 * KBUF + 3 * VBUF; };

template <int DQK, int MODE>
__device__ __forceinline__ void attn_unit(LAS unsigned char* lds, const bf16_t* qptr, const bf16_t* kbase, int kstride, const bf16_t* vtbase,
                                          int tile_lo, int tile_hi, int wlo, int whi, int a0  , int a1  ,
                                          float m_init, float l_init, bf16_t* optr) {
    typedef AG<DQK> G;
    int tid = threadIdx.x; asm volatile("" : "+v"(tid));
    const int lane = tid & 63, r32 = lane & 31, hh = lane >> 5;
    bf16x8 qf[DQK / 16];
#pragma unroll
    for (int dc = 0; dc < DQK / 16; ++dc) qf[dc] = *(const bf16x8*)(qptr + dc * 16 + hh * 8);
    f32x16 O[4];
#pragma unroll
    for (int i = 0; i < 4; ++i)
#pragma unroll
        for (int j = 0; j < 16; ++j) O[i][j] = 0.f;
    float m = m_init, l = l_init;
    const int nt = tile_hi - tile_lo;
    u32x4 kreg[G::KC], vreg[2];
    int krow_[G::KC], kcc_[G::KC];
#pragma unroll
    for (int i = 0; i < G::KC; ++i) { const int cid = tid + i * 512; krow_[i] = cid / (DQK / 8); kcc_[i] = cid % (DQK / 8); }
#define ATT_LOAD(tile) do { const size_t key0 = (size_t)(tile) * 64; \
        _Pragma("unroll") for (int i = 0; i < G::KC; ++i) kreg[i] = *(const u32x4*)(kbase + (key0 + krow_[i]) * kstride + kcc_[i] * 8); \
        _Pragma("unroll") for (int i = 0; i < 2; ++i) { const int cid = tid + i * 512; vreg[i] = *(const u32x4*)(vtbase + (size_t)(cid >> 3) * M + key0 + (cid & 7) * 8); } } while (0)
#define ATT_WRITE(kslot, vslot) do { LAS unsigned char* kb_ = lds + (kslot) * G::KBUF; LAS unsigned char* vb_ = lds + G::VOFF + (vslot) * G::VBUF; \
        _Pragma("unroll") for (int i = 0; i < G::KC; ++i) *(LAS u32x4*)(kb_ + krow_[i] * G::KROW + kcc_[i] * 16) = kreg[i]; \
        _Pragma("unroll") for (int i = 0; i < 2; ++i) { const int cid = tid + i * 512; *(LAS u32x4*)(vb_ + (cid >> 3) * G::VROW + (cid & 7) * 16) = vreg[i]; } } while (0)
#define ATT_PV(vslot) do { const LAS unsigned char* vb = lds + G::VOFF + (vslot) * G::VBUF; \
        _Pragma("unroll") for (int db = 0; db < 4; ++db) _Pragma("unroll") for (int ks = 0; ks < 4; ++ks) { \
            const bf16x8 va = *(const LAS bf16x8*)(vb + (db * 32 + r32) * G::VROW + ks * 32 + hh * 16); \
            O[db] = __builtin_amdgcn_mfma_f32_32x32x16_bf16(va, pf[ks], O[db], 0, 0, 0); } } while (0)
    const bool late = __builtin_amdgcn_readfirstlane(tid >> 6) >= 4;
    bf16x8 pf[4]; bool have_pf = false; int vprev = 0;
#pragma unroll
    for (int i = 0; i < 4; ++i) pf[i] = (bf16x8){0, 0, 0, 0, 0, 0, 0, 0};
    ATT_LOAD(tile_lo); ATT_WRITE(0, 0);
    __syncthreads();
    int vcur = 0;
    for (int it = 0; it < nt; ++it) {
        const int tile = tile_lo + it, buf = it & 1;
        const int vnext = (vcur == 2) ? 0 : vcur + 1;
        if (it + 1 < nt) ATT_LOAD(tile + 1);
        if (late && have_pf) { ATT_PV(vprev); have_pf = false; }
        if (tile >= wlo && tile < whi) {
            const LAS unsigned char* kb = lds + buf * G::KBUF;
            f32x16 S0, S1;
#pragma unroll
            for (int j = 0; j < 16; ++j) { S0[j] = 0.f; S1[j] = 0.f; }
#pragma unroll
            for (int dc = 0; dc < DQK / 16; ++dc) {
                const bf16x8 ka = *(const LAS bf16x8*)(kb + r32 * G::KROW + dc * 32 + hh * 16);
                const bf16x8 kb2 = *(const LAS bf16x8*)(kb + (32 + r32) * G::KROW + dc * 32 + hh * 16);
                S0 = __builtin_amdgcn_mfma_f32_32x32x16_bf16(ka, qf[dc], S0, 0, 0, 0);
                S1 = __builtin_amdgcn_mfma_f32_32x32x16_bf16(kb2, qf[dc], S1, 0, 0, 0);
            }
            if (MODE == 1) {
                const LAS float* rpbL = (const LAS float*)(lds + G::RPB_OFF);
                const int c = a0; int cs = c - 8; cs = cs < 0 ? 0 : (cs > 48 ? 48 : cs);
                const LAS float* rrow = rpbL + (tile + a1) * 31;
                int cb = 4 * hh + 15 - c, vb_ = 4 * hh - cs; asm volatile("" : "+v"(cb), "+v"(vb_));
                float bb0[16], bb1[16];
#pragma unroll
                for (int j = 0; j < 16; ++j) {
                    const int kk = (j & 3) + 8 * (j >> 2);
                    int i0 = kk + cb; i0 = i0 < 0 ? 0 : (i0 > 30 ? 30 : i0); int i1 = kk + 32 + cb; i1 = i1 < 0 ? 0 : (i1 > 30 ? 30 : i1);
                    bb0[j] = rrow[i0]; bb1[j] = rrow[i1];
                }
#pragma unroll
                for (int j = 0; j < 16; ++j) asm volatile("" : "+v"(bb0[j]), "+v"(bb1[j]));
#pragma unroll
                for (int j = 0; j < 16; ++j) {
                    const int kk = (j & 3) + 8 * (j >> 2);
                    S0[j] = ((unsigned)(kk + vb_) < 16u) ? S0[j] + bb0[j] : -INFINITY;
                    S1[j] = ((unsigned)(kk + 32 + vb_) < 16u) ? S1[j] + bb1[j] : -INFINITY;
                }
            }
            if (MODE == 2) {
                const int dbase = tile * 64 - a0;
#pragma unroll
                for (int j = 0; j < 16; ++j) {
                    const int d0 = dbase + crow(j, hh), d1 = d0 + 32;
                    S0[j] = (d0 >= -128 && d0 <= 128) ? S0[j] : -INFINITY;
                    S1[j] = (d1 >= -128 && d1 <= 128) ? S1[j] : -INFINITY;
                }
            }
            float pmax = S0[0];
#pragma unroll
            for (int j = 1; j < 16; ++j) pmax = fmaxf(pmax, S0[j]);
#pragma unroll
            for (int j = 0; j < 16; ++j) pmax = fmaxf(pmax, S1[j]);
            { auto rr = __builtin_amdgcn_permlane32_swap(__float_as_uint(pmax), __float_as_uint(pmax), false, false); pmax = fmaxf(__uint_as_float(rr[0]), __uint_as_float(rr[1])); }
            if (!__all(pmax - m <= 8.0f)) {
                const float mn2 = fmaxf(m, pmax); const float alpha = __builtin_amdgcn_exp2f(m - mn2); m = mn2; l *= alpha;
#pragma unroll
                for (int i = 0; i < 4; ++i)
#pragma unroll
                    for (int j = 0; j < 16; ++j) O[i][j] *= alpha;
            }
            const float mn = m;
            float ps = 0.f;
#pragma unroll
            for (int j = 0; j < 16; ++j) { S0[j] = __builtin_amdgcn_exp2f(S0[j] - mn); S1[j] = __builtin_amdgcn_exp2f(S1[j] - mn); ps += S0[j] + S1[j]; }
            l += ps;
            { u32x4 w;
              w.x = cvt_pk_bf16(S0[0], S0[1]); w.y = cvt_pk_bf16(S0[2], S0[3]); w.z = cvt_pk_bf16(S0[4], S0[5]); w.w = cvt_pk_bf16(S0[6], S0[7]); pf[0] = *(bf16x8*)&w;
              w.x = cvt_pk_bf16(S0[8], S0[9]); w.y = cvt_pk_bf16(S0[10], S0[11]); w.z = cvt_pk_bf16(S0[12], S0[13]); w.w = cvt_pk_bf16(S0[14], S0[15]); pf[1] = *(bf16x8*)&w;
              w.x = cvt_pk_bf16(S1[0], S1[1]); w.y = cvt_pk_bf16(S1[2], S1[3]); w.z = cvt_pk_bf16(S1[4], S1[5]); w.w = cvt_pk_bf16(S1[6], S1[7]); pf[2] = *(bf16x8*)&w;
              w.x = cvt_pk_bf16(S1[8], S1[9]); w.y = cvt_pk_bf16(S1[10], S1[11]); w.z = cvt_pk_bf16(S1[12], S1[13]); w.w = cvt_pk_bf16(S1[14], S1[15]); pf[3] = *(bf16x8*)&w; }
            if (!late) ATT_PV(vcur); else { have_pf = true; vprev = vcur; }
        }
        if (it + 1 < nt) ATT_WRITE(buf ^ 1, vnext);
        vcur = vnext;
        __syncthreads();
    }
    if (late && have_pf) ATT_PV(vprev);
#undef ATT_LOAD
#undef ATT_WRITE
#undef ATT_PV
    { auto rr = __builtin_amdgcn_permlane32_swap(__float_as_uint(l), __float_as_uint(l), false, false); l = __uint_as_float(rr[0]) + __uint_as_float(rr[1]); }
    const float inv = 1.0f / l;
#pragma unroll
    for (int db = 0; db < 4; ++db)
#pragma unroll
        for (int t = 0; t < 2; ++t) {
            const unsigned x0 = cvt_pk_bf16(O[db][8 * t + 0] * inv, O[db][8 * t + 1] * inv), x1 = cvt_pk_bf16(O[db][8 * t + 2] * inv, O[db][8 * t + 3] * inv);
            const unsigned y0 = cvt_pk_bf16(O[db][8 * t + 4] * inv, O[db][8 * t + 5] * inv), y1 = cvt_pk_bf16(O[db][8 * t + 6] * inv, O[db][8 * t + 7] * inv);
            auto r0 = __builtin_amdgcn_permlane32_swap(x0, y0, false, false); auto r1 = __builtin_amdgcn_permlane32_swap(x1, y1, false, false);
            u32x4 w = {r0[0], r1[0], r0[1], r1[1]};
            *(u32x4*)(optr + db * 32 + 16 * t + 8 * hh) = w;
        }
    __syncthreads();
}

__global__ void __launch_bounds__(NTHREADS, 2) fwd_megakernel(Params P) {
    extern __shared__ __attribute__((aligned(16))) unsigned char lds_raw[];
    LAS unsigned char* lds = (LAS unsigned char*)lds_raw;
    cg::grid_group grid = cg::this_grid();
    if (threadIdx.x < 4) ((LAS unsigned*)(lds + LDS_BYTES - 16))[threadIdx.x] = 0u;
    __syncthreads();
    XcdBarrier xbar;
    { KARG(kpb); xbar = xcd_barrier_post((unsigned*)(kpb->ws + WS_BAR), (volatile LAS unsigned*)(lds + LDS_BYTES - 16)); }
#define GRID_SYNC() xcd_barrier(xbar)
    { KARG(kpc); if (kpc->ws == nullptr) grid.sync(); }
#define PHASE_VARS \
    KARG(kp); unsigned char* ws = kp->ws; float* X = kp->out; \
    int tid = threadIdx.x; asm volatile("" : "+v"(tid)); const int lane = tid & 63, wave = __builtin_amdgcn_readfirstlane(tid >> 6); \
    int bid = blockIdx.x; asm volatile("" : "+s"(bid)); const int G = gridDim.x; const int gw = bid * NWAVES + wave, ngw = G * NWAVES; \
    bf16_t* H = (bf16_t*)(ws + WS_H); bf16_t* E = (bf16_t*)(ws + WS_E); bf16_t* PB = (bf16_t*)(ws + WS_PB); \
    float* SS = (float*)(ws + WS_SS); float* ROPE64 = (float*)(ws + WS_ROPE64); float* ROPE128 = (float*)(ws + WS_ROPE128); \
    LAS float* scr = (LAS float*)(lds + wave * 16640); \
    (void)X; (void)H; (void)E; (void)PB; (void)SS; (void)ROPE64; (void)ROPE128; (void)scr; (void)gw; (void)ngw; (void)lane; (void)G

    if (PH(0)) {
        PHASE_VARS;
        _Pragma("unroll 1") for (int rep_ = 0; rep_ < REP_CONV; ++rep_) {
        convert_matrix(kp->in[I_WUP], D, DFF, (bf16_t*)(ws + W_UP), scr, gw, ngw, lane, kp->in[I_MLP_NORM]);
        convert_matrix(kp->in[I_WDOWN], DFF, D, (bf16_t*)(ws + W_DOWN), scr, gw, ngw, lane);
        convert_matrix(kp->in[I_PLE_GATE], D, D, (bf16_t*)(ws + W_GATE), scr, gw, ngw, lane);
        convert_matrix(kp->in[I_PLE_PROJ], 256, D, (bf16_t*)(ws + W_PROJ), scr, gw, ngw, lane);
        convert_matrix(kp->in[I_EV_WIN], D, EV_IN, (bf16_t*)(ws + W_EVIN), scr, gw, ngw, lane);
        convert_matrix(kp->in[I_WQB], 512, 1536, (bf16_t*)(ws + W_QB), scr, gw, ngw, lane);
        convert_matrix(kp->in[I_WKVB], 256, 2048, (bf16_t*)(ws + W_KVB), scr, gw, ngw, lane);
        convert_matrix(kp->in[I_EV_WOUT], D, D, (bf16_t*)(ws + W_EVOUT), scr, gw, ngw, lane);
        }
        for (int i = bid * NTHREADS + tid; i < 4096 * 32; i += G * NTHREADS) { const int pos = i >> 5, f = i & 31;
            const float inv = exp2f(-(float)(2 * f) / 64.0f * 13.287712379549449f);
            double rev = (double)pos * (double)inv * 0.15915494309189535; rev -= floor(rev);
            ROPE64[i] = __builtin_amdgcn_cosf((float)rev); ROPE64[4096 * 32 + i] = __builtin_amdgcn_sinf((float)rev); }
        for (int i = bid * NTHREADS + tid; i < 4096 * 64; i += G * NTHREADS) { const int pos = i >> 6, f = i & 63;
            const float inv = exp2f(-(float)(2 * f) / 128.0f * 13.287712379549449f);
            double rev = (double)pos * (double)inv * 0.15915494309189535; rev -= floor(rev);
            ROPE128[i] = __builtin_amdgcn_cosf((float)rev); ROPE128[4096 * 64 + i] = __builtin_amdgcn_sinf((float)rev); }
        _Pragma("unroll 1") for (int rp_ = 0; rp_ < REP_PREP; ++rp_) for (int row = gw; row < M; row += ngw) {
            const float* xr = row < 8192 ? kp->in[I_XP] + (size_t)row * D : kp->in[I_XS] + (size_t)(row - 8192) * D;
            norm_row(xr, kp->in[I_ATTN_NORM], H + (size_t)row * D, nullptr, lane);
            const float* pr = row < 8192 ? kp->in[I_PP] + (size_t)row * 256 : kp->in[I_PS] + (size_t)(row - 8192) * 256;
            conv_p_row(pr, PB + (size_t)row * 256, lane);
            conv_p_row(pr + (size_t)8192 * 256, (bf16_t*)(ws + WS_PB1) + (size_t)row * 256, lane);
        }
        for (int i = bid * NTHREADS + tid; i < 5 * M; i += G * NTHREADS) SS[i] = 0.f;
    }
    GRID_SYNC();

    if (PH(1)) { PHASE_VARS; pg8::EpiBf16<0> Ep{(bf16_t*)(ws + B_Z), EV_INP, nullptr, nullptr}; pg8::run_gemm(lds, H, (const bf16_t*)(ws + W_EVIN), EV_INP, D, Ep); }
    GRID_SYNC();

    if (PH(2)) {
        PHASE_VARS;
        const bf16_t* Z = (const bf16_t*)(ws + B_Z);
        bf16_t* QN = (bf16_t*)(ws + B_QN); bf16_t* KVN = (bf16_t*)(ws + B_KVN); bf16_t* KR = (bf16_t*)(ws + B_KR);
        bf16_t* NQ = (bf16_t*)(ws + B_NQ); bf16_t* NK = (bf16_t*)(ws + B_NK); bf16_t* NVT = (bf16_t*)(ws + B_NVT);
        const float CNA = 0.08838834764831845f * LOG2E;
        _Pragma("unroll 1") for (int rp_ = 0; rp_ < REP_PREP; ++rp_) for (int tok = gw; tok < M; tok += ngw) {
            const bf16_t* z = Z + (size_t)tok * EV_INP; const int pos = tok_pos(tok);
            { const u32x4 w = *(const u32x4*)(z + 8 * lane);
              float v[8] = {bflo(w.x), bfhi(w.x), bflo(w.y), bfhi(w.y), bflo(w.z), bfhi(w.z), bflo(w.w), bfhi(w.w)}; float s = 0.f;
#pragma unroll
              for (int j = 0; j < 8; ++j) s += v[j] * v[j];
              const float ri = 1.0f / sqrtf(wave_sum(s) * (1.f / 512.f) + EPS); const float* g = kp->in[I_QA_NORM] + 8 * lane;
              u32x4 o; o.x = cvt_pk_bf16(v[0] * ri * g[0], v[1] * ri * g[1]); o.y = cvt_pk_bf16(v[2] * ri * g[2], v[3] * ri * g[3]); o.z = cvt_pk_bf16(v[4] * ri * g[4], v[5] * ri * g[5]); o.w = cvt_pk_bf16(v[6] * ri * g[6], v[7] * ri * g[7]);
              *(u32x4*)(QN + (size_t)tok * 512 + 8 * lane) = o; }
            { const u32x2 w = *(const u32x2*)(z + 512 + 4 * lane);
              float v[4] = {bflo(w.x), bfhi(w.x), bflo(w.y), bfhi(w.y)}; const float s = (v[0] * v[0] + v[1] * v[1]) + (v[2] * v[2] + v[3] * v[3]);
              const float ri = 1.0f / sqrtf(wave_sum(s) * (1.f / 256.f) + EPS); const float* g = kp->in[I_KVA_NORM] + 4 * lane;
              u32x2 o; o.x = cvt_pk_bf16(v[0] * ri * g[0], v[1] * ri * g[1]); o.y = cvt_pk_bf16(v[2] * ri * g[2], v[3] * ri * g[3]);
              *(u32x2*)(KVN + (size_t)tok * 256 + 4 * lane) = o; }
            { const float v = bf2f(z[768 + lane]); const float ri = 1.0f / sqrtf(wave_sum(v * v) * (1.f / 64.f) + EPS);
              const float y = v * ri * kp->in[I_KROPE_NORM][lane]; const float yp = __shfl_xor(y, 32);
              const float c = ROPE64[pos * 32 + (lane & 31)], s = ROPE64[4096 * 32 + pos * 32 + (lane & 31)];
              const float o = lane < 32 ? y * c - yp * s : y * c + yp * s;
              KR[(size_t)tok * 64 + lane] = f2bf(o); }
#pragma unroll
            for (int p = 0; p < 2; ++p) {
                const int d0 = 8 * (lane & 15);
                { const u32x4 w = *(const u32x4*)(z + 832 + p * 512 + 8 * lane);
                  float v[8] = {bflo(w.x), bfhi(w.x), bflo(w.y), bfhi(w.y), bflo(w.z), bfhi(w.z), bflo(w.w), bfhi(w.w)}; float s = 0.f;
#pragma unroll
                  for (int j = 0; j < 8; ++j) s += v[j] * v[j];
                  const float ri = CNA / sqrtf(group_sum<16>(s) * (1.f / 128.f) + EPS); const float* g = kp->in[I_NAQ_NORM] + d0;
                  u32x4 o; o.x = cvt_pk_bf16(v[0] * ri * g[0], v[1] * ri * g[1]); o.y = cvt_pk_bf16(v[2] * ri * g[2], v[3] * ri * g[3]); o.z = cvt_pk_bf16(v[4] * ri * g[4], v[5] * ri * g[5]); o.w = cvt_pk_bf16(v[6] * ri * g[6], v[7] * ri * g[7]);
                  *(u32x4*)(NQ + (size_t)tok * 1024 + p * 512 + 8 * lane) = o; }
                { const u32x4 w = *(const u32x4*)(z + 1856 + p * 512 + 8 * lane);
                  float v[8] = {bflo(w.x), bfhi(w.x), bflo(w.y), bfhi(w.y), bflo(w.z), bfhi(w.z), bflo(w.w), bfhi(w.w)}; float s = 0.f;
#pragma unroll
                  for (int j = 0; j < 8; ++j) s += v[j] * v[j];
                  const float ri = 1.0f / sqrtf(group_sum<16>(s) * (1.f / 128.f) + EPS); const float* g = kp->in[I_NAK_NORM] + d0;
                  u32x4 o; o.x = cvt_pk_bf16(v[0] * ri * g[0], v[1] * ri * g[1]); o.y = cvt_pk_bf16(v[2] * ri * g[2], v[3] * ri * g[3]); o.z = cvt_pk_bf16(v[4] * ri * g[4], v[5] * ri * g[5]); o.w = cvt_pk_bf16(v[6] * ri * g[6], v[7] * ri * g[7]);
                  *(u32x4*)(NK + (size_t)tok * 1024 + p * 512 + 8 * lane) = o; }
            }
        }
        __syncthreads();
        _Pragma("unroll 1") for (int rp_ = 0; rp_ < REP_PREP; ++rp_) for (int it = bid; it < 256 * 8; it += G) { const int tt = it >> 3, h = it & 7;
            vt_item(lds, Z + (size_t)(tt * 64) * EV_INP + 2880 + h * 128, EV_INP, NVT + (size_t)(h * 128) * M, tt * 64); }
    }
    GRID_SYNC();

    if (PH(3)) { PHASE_VARS; pg8::EpiBf16<0> Ep{(bf16_t*)(ws + B_Q1), 1536, nullptr, nullptr}; pg8::run_gemm(lds, (const bf16_t*)(ws + B_QN), (const bf16_t*)(ws + W_QB), 1536, 512, Ep); }
    if (PH(3)) { PHASE_VARS; pg8::EpiBf16<0> Ep{(bf16_t*)(ws + B_KV1), 2048, nullptr, nullptr}; pg8::run_gemm(lds, (const bf16_t*)(ws + B_KVN), (const bf16_t*)(ws + W_KVB), 2048, 256, Ep); }
    GRID_SYNC();

    if (PH(4)) {
        PHASE_VARS;
        const bf16_t* Q1 = (const bf16_t*)(ws + B_Q1); const bf16_t* KV1 = (const bf16_t*)(ws + B_KV1); const bf16_t* KR = (const bf16_t*)(ws + B_KR);
        bf16_t* QM = (bf16_t*)(ws + HE_QM); bf16_t* KM = (bf16_t*)(ws + HE_KM); bf16_t* VTM = (bf16_t*)(ws + HE_VTM);
        const float CM = 0.07216878364870323f * LOG2E;
        const int hq = lane >> 3, sl = lane & 7;
        float gqn[16], gkn[16], gqr[8];
#pragma unroll
        for (int j = 0; j < 16; ++j) { gqn[j] = kp->in[I_QNOPE_NORM][sl * 16 + j]; gkn[j] = kp->in[I_KNOPE_NORM][sl * 16 + j]; }
#pragma unroll
        for (int j = 0; j < 8; ++j) gqr[j] = kp->in[I_QROPE_NORM][sl * 8 + j];
        _Pragma("unroll 1") for (int rp_ = 0; rp_ < REP_PREP; ++rp_) for (int tok = gw; tok < M; tok += ngw) {
            const int pos = tok_pos(tok);
            const bf16_t* q = Q1 + (size_t)tok * 1536 + hq * 192; bf16_t* qo = QM + (size_t)tok * 1536 + hq * 192;
            const bf16_t* k = KV1 + (size_t)tok * 2048 + hq * 256; bf16_t* ko = KM + (size_t)tok * 1536 + hq * 192;
            const u32x4 qa = *(const u32x4*)(q + sl * 16), qb = *(const u32x4*)(q + sl * 16 + 8), qr = *(const u32x4*)(q + 128 + sl * 8);
            const u32x4 ka = *(const u32x4*)(k + sl * 16), kb = *(const u32x4*)(k + sl * 16 + 8), krv = *(const u32x4*)(KR + (size_t)tok * 64 + sl * 8);
            const f32x4 c0 = *(const f32x4*)(ROPE64 + pos * 32 + (sl & 3) * 8), c1 = *(const f32x4*)(ROPE64 + pos * 32 + (sl & 3) * 8 + 4);
            const f32x4 s0 = *(const f32x4*)(ROPE64 + 4096 * 32 + pos * 32 + (sl & 3) * 8), s1 = *(const f32x4*)(ROPE64 + 4096 * 32 + pos * 32 + (sl & 3) * 8 + 4);
            { float v[16] = {bflo(qa.x), bfhi(qa.x), bflo(qa.y), bfhi(qa.y), bflo(qa.z), bfhi(qa.z), bflo(qa.w), bfhi(qa.w), bflo(qb.x), bfhi(qb.x), bflo(qb.y), bfhi(qb.y), bflo(qb.z), bfhi(qb.z), bflo(qb.w), bfhi(qb.w)};
              float ss = 0.f;
#pragma unroll
              for (int j = 0; j < 16; ++j) ss += v[j] * v[j];
              const float ri = CM / sqrtf(group_sum<8>(ss) * (1.f / 128.f) + EPS);
              u32x4 o0, o1;
              o0.x = cvt_pk_bf16(v[0] * ri * gqn[0], v[1] * ri * gqn[1]); o0.y = cvt_pk_bf16(v[2] * ri * gqn[2], v[3] * ri * gqn[3]); o0.z = cvt_pk_bf16(v[4] * ri * gqn[4], v[5] * ri * gqn[5]); o0.w = cvt_pk_bf16(v[6] * ri * gqn[6], v[7] * ri * gqn[7]);
              o1.x = cvt_pk_bf16(v[8] * ri * gqn[8], v[9] * ri * gqn[9]); o1.y = cvt_pk_bf16(v[10] * ri * gqn[10], v[11] * ri * gqn[11]); o1.z = cvt_pk_bf16(v[12] * ri * gqn[12], v[13] * ri * gqn[13]); o1.w = cvt_pk_bf16(v[14] * ri * gqn[14], v[15] * ri * gqn[15]);
              *(u32x4*)(qo + sl * 16) = o0; *(u32x4*)(qo + sl * 16 + 8) = o1; }
            { float v[8] = {bflo(qr.x), bfhi(qr.x), bflo(qr.y), bfhi(qr.y), bflo(qr.z), bfhi(qr.z), bflo(qr.w), bfhi(qr.w)};
              const float cc[8] = {c0[0], c0[1], c0[2], c0[3], c1[0], c1[1], c1[2], c1[3]}, sn[8] = {s0[0], s0[1], s0[2], s0[3], s1[0], s1[1], s1[2], s1[3]};
              float ss = 0.f;
#pragma unroll
              for (int j = 0; j < 8; ++j) ss += v[j] * v[j];
              const float ri = 1.0f / sqrtf(group_sum<8>(ss) * (1.f / 64.f) + EPS);
              float o[8];
#pragma unroll
              for (int j = 0; j < 8; ++j) { const float y = v[j] * ri * gqr[j]; const float yp = __shfl_xor(y, 4); o[j] = (sl < 4 ? y * cc[j] - yp * sn[j] : y * cc[j] + yp * sn[j]) * CM; }
              u32x4 w; w.x = cvt_pk_bf16(o[0], o[1]); w.y = cvt_pk_bf16(o[2], o[3]); w.z = cvt_pk_bf16(o[4], o[5]); w.w = cvt_pk_bf16(o[6], o[7]);
              *(u32x4*)(qo + 128 + sl * 8) = w; }
            { float v[16] = {bflo(ka.x), bfhi(ka.x), bflo(ka.y), bfhi(ka.y), bflo(ka.z), bfhi(ka.z), bflo(ka.w), bfhi(ka.w), bflo(kb.x), bfhi(kb.x), bflo(kb.y), bfhi(kb.y), bflo(kb.z), bfhi(kb.z), bflo(kb.w), bfhi(kb.w)};
              float ss = 0.f;
#pragma unroll
              for (int j = 0; j < 16; ++j) ss += v[j] * v[j];
              const float ri = 1.0f / sqrtf(group_sum<8>(ss) * (1.f / 128.f) + EPS);
              u32x4 o0, o1;
              o0.x = cvt_pk_bf16(v[0] * ri * gkn[0], v[1] * ri * gkn[1]); o0.y = cvt_pk_bf16(v[2] * ri * gkn[2], v[3] * ri * gkn[3]); o0.z = cvt_pk_bf16(v[4] * ri * gkn[4], v[5] * ri * gkn[5]); o0.w = cvt_pk_bf16(v[6] * ri * gkn[6], v[7] * ri * gkn[7]);
              o1.x = cvt_pk_bf16(v[8] * ri * gkn[8], v[9] * ri * gkn[9]); o1.y = cvt_pk_bf16(v[10] * ri * gkn[10], v[11] * ri * gkn[11]); o1.z = cvt_pk_bf16(v[12] * ri * gkn[12], v[13] * ri * gkn[13]); o1.w = cvt_pk_bf16(v[14] * ri * gkn[14], v[15] * ri * gkn[15]);
              *(u32x4*)(ko + sl * 16) = o0; *(u32x4*)(ko + sl * 16 + 8) = o1; }
            *(u32x4*)(ko + 128 + sl * 8) = krv;
        }
        __syncthreads();
        _Pragma("unroll 1") for (int rp_ = 0; rp_ < REP_PREP; ++rp_) for (int it = bid; it < 256 * 8; it += G) { const int tt = it >> 3, h = it & 7;
            vt_item(lds, KV1 + (size_t)(tt * 64) * 2048 + h * 256 + 128, 2048, VTM + (size_t)(h * 128) * M, tt * 64); }
    }
    GRID_SYNC();

    if (PH(5)) {
        PHASE_VARS;
        const bf16_t* QM = (const bf16_t*)(ws + HE_QM); const bf16_t* KM = (const bf16_t*)(ws + HE_KM); const bf16_t* VTM = (const bf16_t*)(ws + HE_VTM);
        const bf16_t* NQ = (const bf16_t*)(ws + B_NQ); const bf16_t* NK = (const bf16_t*)(ws + B_NK); const bf16_t* NVT = (const bf16_t*)(ws + B_NVT);
        bf16_t* OC = (bf16_t*)(ws + B_OCAT0);
        _Pragma("unroll 1") for (int rep_ = 0; rep_ < REP_MLA; ++rep_)
        for (int u = bid; u < 512; u += G) {
            int seqbase, T, h, qb;
            int uu = u; if (G == 256) { const int b = u & 255, x = b & 7, j = b >> 3; uu = (u < 256) ? (x * 2 + (j >> 4)) * 16 + (j & 15) : 256 + (x * 4 + (j >> 3)) * 8 + (j & 7); }
            if (uu < 256) { const int s = uu >> 7; seqbase = s * 4096; T = 4096; h = (uu >> 4) & 7; qb = uu & 15; }
            else { const int v = uu - 256; const int s = v >> 6; seqbase = 8192 + s * 2048; T = 2048; h = (v >> 3) & 7; qb = v & 7; }
            const int tq = seqbase + qb * 256 + wave * 32 + (lane & 31);
            const int t0 = seqbase >> 6, t1 = (seqbase + T) >> 6;
            attn_unit<192, 0>(lds, QM + (size_t)tq * 1536 + h * 192, KM + h * 192, 1536, VTM + (size_t)(h * 128) * M, t0, t1, t0, t1, 0, 0, -1e30f, 0.f, OC + (size_t)tq * 2048 + h * 128);
        }
        _Pragma("unroll 1") for (int rep_ = 0; rep_ < REP_NA; ++rep_)
        for (int u = bid; u < 512; u += G) {
            int seqbase, rows, h, rg;
            int uu = u; if (G == 256) { const int b = u & 255, x = b & 7, j = b >> 3; uu = (u < 256) ? (x * 2 + (j >> 4)) * 16 + (j & 15) : 256 + (x * 4 + (j >> 3)) * 8 + (j & 7); }
            if (uu < 256) { const int s = uu >> 7; seqbase = s * 4096; rows = 64; h = (uu >> 4) & 7; rg = uu & 15; }
            else { const int v = uu - 256; const int s = v >> 6; seqbase = 8192 + s * 2048; rows = 32; h = (v >> 3) & 7; rg = v & 7; }
            { LAS float* rpbL = (LAS float*)(lds + AG<128>::RPB_OFF); for (int i = tid; i < 465; i += NTHREADS) rpbL[i] = kp->in[I_RPB][h * 465 + i] * LOG2E; }
            const int r = rg * 4 + (wave >> 1), c = (wave & 1) * 32 + (lane & 31);
            const int tq = seqbase + r * 64 + c;
            const int st0 = seqbase >> 6;
            int rs_lo = rg * 4 - 4; rs_lo = rs_lo < 0 ? 0 : (rs_lo > rows - 8 ? rows - 8 : rs_lo);
            int rs_hi = rg * 4 + 3 - 4; rs_hi = rs_hi < 0 ? 0 : (rs_hi > rows - 8 ? rows - 8 : rs_hi);
            int rs = r - 4; rs = rs < 0 ? 0 : (rs > rows - 8 ? rows - 8 : rs);
            attn_unit<128, 1>(lds, NQ + (size_t)tq * 1024 + h * 128, NK + h * 128, 1024, NVT + (size_t)(h * 128) * M, st0 + rs_lo, st0 + rs_hi + 8, st0 + rs, st0 + rs + 8, c, 7 - r - st0, -1e30f, 0.f,
                              OC + (size_t)tq * 2048 + 1024 + h * 128);
        }
    }
    GRID_SYNC();

    if (PH(6)) { PHASE_VARS; pg8::EpiResidB Ep{nullptr, kp->in[I_XP], kp->in[I_XS], H, SS + 0 * M, nullptr}; pg8::run_gemm(lds, (const bf16_t*)(ws + B_OCAT0), (const bf16_t*)(ws + W_EVOUT), D, D, Ep); }
    if (PH(6)) { PHASE_VARS; pg8::EpiBf16<0> Ep{E, D, nullptr, SS + 3 * M}; pg8::run_gemm(lds, PB, (const bf16_t*)(ws + W_PROJ), D, 256, Ep); }
    GRID_SYNC();

    if (PH(9)) { PHASE_VARS; pg8::EpiBf16<1> Ep{(bf16_t*)(ws + B_ACT), DFF, nullptr, nullptr};
        const int ksp = (G == 256) ? ((bid >> 3) & 7) : (1 << 20);
        pg8::run_gemm(lds, H, (const bf16_t*)(ws + W_UP), DFF, D, Ep, 0, ksp);
        convert_matrix(kp->in[I_OD_WIN], D, OD_IN, (bf16_t*)(ws + W_ODIN), scr, gw, ngw, lane, kp->in[I_ATTN_NORM] + D);
        convert_matrix(kp->in[I_OD_WOUT], D, D, (bf16_t*)(ws + W_ODOUT), scr, gw, ngw, lane);
        convert_matrix(kp->in[I_PLE_GATE] + (size_t)D * D, D, D, (bf16_t*)(ws + W_GATE1), scr, gw, ngw, lane);
        convert_matrix(kp->in[I_PLE_PROJ] + (size_t)256 * D, 256, D, (bf16_t*)(ws + W_PROJ), scr, gw, ngw, lane);
        __syncthreads();
        pg8::run_gemm(lds, H, (const bf16_t*)(ws + W_UP), DFF, D, Ep, ksp, 1 << 20); }
    GRID_SYNC();
    if (PH(10)) { PHASE_VARS; pg8::EpiResidB Ep{H, nullptr, nullptr, (bf16_t*)X, nullptr, SS + 0 * M};
        const int ksp = (G == 256) ? ((bid >> 3) % 3) : (1 << 20);
        pg8::run_gemm(lds, (const bf16_t*)(ws + B_ACT), (const bf16_t*)(ws + W_DOWN), D, DFF, Ep, 0, ksp);
        convert_matrix(kp->in[I_WUP] + (size_t)D * DFF, D, DFF, (bf16_t*)(ws + W_UP), scr, gw, ngw, lane, kp->in[I_MLP_NORM] + D);
        __syncthreads();
        pg8::run_gemm(lds, (const bf16_t*)(ws + B_ACT), (const bf16_t*)(ws + W_DOWN), D, DFF, Ep, ksp, 1 << 20); }
    GRID_SYNC();
    if (PH(11)) { PHASE_VARS; pg8::EpiGateB Ep{(const bf16_t*)X, E, SS + 3 * M, kp->in[I_PLE_NORM], H, SS + 2 * M, nullptr};
        const int ksp = (G == 256) ? ((bid >> 3) % 3) : (1 << 20);
        pg8::run_gemm(lds, (const bf16_t*)X, (const bf16_t*)(ws + W_GATE), D, D, Ep, 0, ksp);
        convert_matrix(kp->in[I_WDOWN] + (size_t)D * DFF, DFF, D, (bf16_t*)(ws + W_DOWN), scr, gw, ngw, lane);
        __syncthreads();
        pg8::run_gemm(lds, (const bf16_t*)X, (const bf16_t*)(ws + W_GATE), D, D, Ep, ksp, 1 << 20); }
    GRID_SYNC();

    if (PH(7)) {
            { PHASE_VARS; pg8::EpiBf16<0> Ep{(bf16_t*)(ws + B_Z), OD_IN, SS + 2 * M, nullptr}; pg8::run_gemm(lds, H, (const bf16_t*)(ws + W_ODIN), OD_IN, D, Ep); }
            GRID_SYNC();
            {
                PHASE_VARS;
                const bf16_t* Z3 = (const bf16_t*)(ws + B_Z); bf16_t* SQ = (bf16_t*)(ws + B_SQ); bf16_t* SK = (bf16_t*)(ws + B_SK); bf16_t* SVT = (bf16_t*)(ws + B_SVT);
                const float CS = 0.08838834764831845f * LOG2E;
                const int hs = lane >> 3, j8 = 8 * (lane & 7);
                float gq[16], gk[16];
#pragma unroll
                for (int j = 0; j < 8; ++j) { gq[j] = kp->in[I_SWAQ_NORM][j8 + j]; gq[8 + j] = kp->in[I_SWAQ_NORM][64 + j8 + j]; gk[j] = kp->in[I_SWAK_NORM][j8 + j]; gk[8 + j] = kp->in[I_SWAK_NORM][64 + j8 + j]; }
                _Pragma("unroll 1") for (int rp_ = 0; rp_ < REP_PREP; ++rp_) for (int tok = gw; tok < M; tok += ngw) {
                    const int pos = tok_pos(tok);
                    const f32x4 c0 = *(const f32x4*)(ROPE128 + pos * 64 + j8), c1 = *(const f32x4*)(ROPE128 + pos * 64 + j8 + 4);
                    const f32x4 s0 = *(const f32x4*)(ROPE128 + 4096 * 64 + pos * 64 + j8), s1 = *(const f32x4*)(ROPE128 + 4096 * 64 + pos * 64 + j8 + 4);
                    const float cc[8] = {c0[0], c0[1], c0[2], c0[3], c1[0], c1[1], c1[2], c1[3]}, sn[8] = {s0[0], s0[1], s0[2], s0[3], s1[0], s1[1], s1[2], s1[3]};
                    const bf16_t* z = Z3 + (size_t)tok * OD_IN;
#pragma unroll
                    for (int p = 0; p < 3; ++p) {
                        const int head = 8 * p + hs; const bool act = head < 20; const int hc = act ? head : 19;
                        const bf16_t* src = z + hc * 128;
                        const u32x4 w1 = *(const u32x4*)(src + j8), w2 = *(const u32x4*)(src + 64 + j8);
                        const float a[8] = {bflo(w1.x), bfhi(w1.x), bflo(w1.y), bfhi(w1.y), bflo(w1.z), bfhi(w1.z), bflo(w1.w), bfhi(w1.w)};
                        const float b[8] = {bflo(w2.x), bfhi(w2.x), bflo(w2.y), bfhi(w2.y), bflo(w2.z), bfhi(w2.z), bflo(w2.w), bfhi(w2.w)};
                        float ss = 0.f;
#pragma unroll
                        for (int j = 0; j < 8; ++j) ss += a[j] * a[j] + b[j] * b[j];
                        const bool isq = hc < 16;
                        const float ri = (isq ? CS : 1.0f) / sqrtf(group_sum<8>(ss) * (1.f / 128.f) + EPS);
                        float o1[8], o2[8];
#pragma unroll
                        for (int j = 0; j < 8; ++j) { const float y1 = a[j] * ri * (isq ? gq[j] : gk[j]), y2 = b[j] * ri * (isq ? gq[8 + j] : gk[8 + j]); o1[j] = y1 * cc[j] - y2 * sn[j]; o2[j] = y2 * cc[j] + y1 * sn[j]; }
                        u32x4 v1, v2;
                        v1.x = cvt_pk_bf16(o1[0], o1[1]); v1.y = cvt_pk_bf16(o1[2], o1[3]); v1.z = cvt_pk_bf16(o1[4], o1[5]); v1.w = cvt_pk_bf16(o1[6], o1[7]);
                        v2.x = cvt_pk_bf16(o2[0], o2[1]); v2.y = cvt_pk_bf16(o2[2], o2[3]); v2.z = cvt_pk_bf16(o2[4], o2[5]); v2.w = cvt_pk_bf16(o2[6], o2[7]);
                        bf16_t* dst = isq ? SQ + (size_t)tok * 2048 + hc * 128 : SK + (size_t)tok * 512 + (hc - 16) * 128;
                        if (act) { *(u32x4*)(dst + j8) = v1; *(u32x4*)(dst + 64 + j8) = v2; }
                    }
                }
                __syncthreads();
                _Pragma("unroll 1") for (int rp_ = 0; rp_ < REP_PREP; ++rp_) for (int it = bid; it < 256 * 4; it += G) { const int tt = it >> 2, h = it & 3;
                    vt_item(lds, Z3 + (size_t)(tt * 64) * OD_IN + 2560 + h * 128, OD_IN, SVT + (size_t)(h * 128) * M, tt * 64); }
            }
            GRID_SYNC();
            {
                PHASE_VARS;
                const bf16_t* SQ = (const bf16_t*)(ws + B_SQ); const bf16_t* SK = (const bf16_t*)(ws + B_SK); const bf16_t* SVT = (const bf16_t*)(ws + B_SVT);
                bf16_t* OC = (bf16_t*)(ws + B_OCAT1);
                _Pragma("unroll 1") for (int rep_ = 0; rep_ < REP_SWA; ++rep_)
                for (int u = bid; u < 1024; u += G) {
                    int kvh = u & 3, ch = u >> 2;
                    if (G == 256) { const int b = u & 255, x = b & 7, j = b >> 3; kvh = u >> 8; ch = 32 * x + j; }
                    const int tok0 = ch * 64;
                    const int seqbase = tok0 < 8192 ? (tok0 & ~4095) : (tok0 & ~2047); const int T = tok0 < 8192 ? 4096 : 2048;
                    const int head = kvh * 4 + (wave >> 1);
                    const int tq = tok0 + (wave & 1) * 32 + (lane & 31);
                    int tlo = ch - 2, thi = ch + 3; const int s0 = seqbase >> 6, s1 = (seqbase + T) >> 6; tlo = tlo < s0 ? s0 : tlo; thi = thi > s1 ? s1 : thi;
                    const float sink = kp->in[I_SINKS][head] * LOG2E;
                    attn_unit<128, 2>(lds, SQ + (size_t)tq * 2048 + head * 128, SK + kvh * 128, 512, SVT + (size_t)(kvh * 128) * M, tlo, thi, tlo, thi, tq, 0, sink, lane < 32 ? 1.f : 0.f,
                                      OC + (size_t)tq * 2048 + head * 128);
                }
            }
            GRID_SYNC();
            { PHASE_VARS; pg8::EpiResidB Ep{H, nullptr, nullptr, (bf16_t*)X, SS + 1 * M, nullptr}; pg8::run_gemm(lds, (const bf16_t*)(ws + B_OCAT1), (const bf16_t*)(ws + W_ODOUT), D, D, Ep); }
            { PHASE_VARS; pg8::EpiBf16<0> Ep{E, D, nullptr, SS + 4 * M}; pg8::run_gemm(lds, (const bf16_t*)(ws + WS_PB1), (const bf16_t*)(ws + W_PROJ), D, 256, Ep); }
            GRID_SYNC();
    }
    if (PH(9)) { PHASE_VARS; pg8::EpiBf16<1> Ep{(bf16_t*)(ws + B_ACT), DFF, nullptr, nullptr}; pg8::run_gemm(lds, (const bf16_t*)X, (const bf16_t*)(ws + W_UP), DFF, D, Ep); }
    GRID_SYNC();
    if (PH(10)) { PHASE_VARS; pg8::EpiResidB Ep{(const bf16_t*)X, nullptr, nullptr, H, nullptr, SS + 1 * M}; pg8::run_gemm(lds, (const bf16_t*)(ws + B_ACT), (const bf16_t*)(ws + W_DOWN), D, DFF, Ep); }
    GRID_SYNC();
    if (PH(11)) { PHASE_VARS; pg8::EpiGateF32 Ep{H, E, SS + 4 * M, kp->in[I_PLE_NORM] + D, X}; pg8::run_gemm(lds, H, (const bf16_t*)(ws + W_GATE1), D, D, Ep); }
}

extern "C" void kernel_launch(void* const* d_in, const int* in_sizes, int n_in, void* d_out, int out_size, void* d_ws, size_t ws_size, hipStream_t stream) {
    static int grid_blocks = 0;
    if (!grid_blocks) {
        int dev = 0, cus = 0, per_cu = 0;
        hipGetDevice(&dev);
        hipDeviceGetAttribute(&cus, hipDeviceAttributeMultiprocessorCount, dev);
        hipFuncSetAttribute((const void*)fwd_megakernel, hipFuncAttributeMaxDynamicSharedMemorySize, LDS_BYTES);
        hipOccupancyMaxActiveBlocksPerMultiprocessor(&per_cu, (const void*)fwd_megakernel, NTHREADS, LDS_BYTES);
        if (per_cu < 1) per_cu = 1;
        grid_blocks = cus * per_cu;
        if (ws_size < WS_END) fprintf(stderr, "kernel_launch: workspace too small: %zu < %zu\n", ws_size, (size_t)WS_END);
    }
    Params p{};
    for (int i = 0; i < N_IN; ++i) p.in[i] = (const float*)d_in[i];
    p.out = (float*)d_out; p.ws = (unsigned char*)d_ws;
    (void)hipMemsetAsync((char*)d_ws + WS_BAR, 0, XCD_BAR_WORDS * sizeof(unsigned), stream);
    void* args[] = {&p};
    hipError_t e = hipLaunchCooperativeKernel((const void*)fwd_megakernel, dim3(grid_blocks), dim3(NTHREADS), args, LDS_BYTES, stream);
    if (e != hipSuccess) fprintf(stderr, "cooperative launch failed: %s (grid %d)\n", hipGetErrorString(e), grid_blocks);
}
```

```cpp
#include <hip/hip_runtime.h>
#include <hip/hip_cooperative_groups.h>
#include <cstdio>
namespace cg = cooperative_groups;

#define LAS __attribute__((address_space(3)))
typedef unsigned short bf16_t;
typedef short bf16x8 __attribute__((ext_vector_type(8)));
typedef float f32x4 __attribute__((ext_vector_type(4)));
typedef float f32x16 __attribute__((ext_vector_type(16)));
typedef unsigned u32x4 __attribute__((ext_vector_type(4)));
typedef unsigned u32x2 __attribute__((ext_vector_type(2)));

constexpr int M = 16384, D = 2048, DFF = 8192;
constexpr int EV_IN = 3904, EV_INP = 4096, OD_IN = 3072;
constexpr float EPS = 1e-6f;
constexpr float LOG2E = 1.4426950408889634f;
constexpr int NTHREADS = 512, NWAVES = 8;
constexpr int LDS_BYTES = 136 * 1024;
#ifndef ONLY
#define ONLY 0xffffffff
#endif
#define PH(b) (((ONLY) >> (b)) & 1u)
#ifndef REP_CONV
#define REP_CONV 1
#endif
#ifndef REP_ATT
#define REP_ATT 1
#endif
#define REP_MLA 1
#define REP_NA 1
#define REP_SWA 1
#ifndef REP_PREP
#define REP_PREP 1
#endif

enum { I_XP = 0, I_XS, I_PP, I_PS, I_ATTN_NORM, I_MLP_NORM, I_WUP, I_WDOWN, I_PLE_GATE, I_PLE_PROJ, I_PLE_NORM, I_EV_WIN, I_QA_NORM, I_WQB, I_KVA_NORM,
       I_WKVB, I_QNOPE_NORM, I_QROPE_NORM, I_KNOPE_NORM, I_KROPE_NORM, I_NAQ_NORM, I_NAK_NORM, I_RPB, I_EV_WOUT, I_OD_WIN, I_SWAQ_NORM, I_SWAK_NORM, I_SINKS, I_OD_WOUT, N_IN };

struct Params { const float* in[N_IN]; float* out; unsigned char* ws; };
typedef const Params __attribute__((address_space(4)))* KP;
#define KARG(name) KP name = (KP)__builtin_amdgcn_kernarg_segment_ptr(); asm volatile("" : "+s"(name))

constexpr size_t MiB = 1024 * 1024;
constexpr size_t W_UP = 0, W_DOWN = 32 * MiB, W_GATE = 64 * MiB, W_PROJ = 72 * MiB, W_MIX = 73 * MiB;
constexpr size_t W_EVIN = W_MIX, W_QB = W_MIX + 16 * MiB, W_KVB = W_QB + 3 * MiB / 2, W_EVOUT = W_KVB + 1 * MiB;
constexpr size_t W_ODIN = W_MIX, W_ODOUT = W_MIX + 12 * MiB;
constexpr size_t WS_H = 100 * MiB, WS_E = 164 * MiB, WS_PB = 228 * MiB, WS_BIG = 236 * MiB, WS_MISC = 492 * MiB;
constexpr size_t WS_BAR = WS_MISC + 512 * 1024;
constexpr size_t WS_SS = WS_MISC;
constexpr size_t WS_ROPE64 = WS_MISC + 1 * MiB, WS_ROPE128 = WS_MISC + 2 * MiB, W_GATE1 = WS_MISC + 4 * MiB, WS_PB1 = WS_MISC + 12 * MiB, WS_END = WS_MISC + 20 * MiB;
constexpr size_t B_H2 = WS_BIG + 192 * MiB;
constexpr size_t B_Z = WS_BIG;
constexpr size_t B_Q1 = WS_BIG, B_KV1 = WS_BIG + 48 * MiB;
constexpr size_t B_NQ = WS_BIG + 128 * MiB, B_NK = WS_BIG + 160 * MiB, B_NVT = WS_BIG + 192 * MiB;
constexpr size_t B_QN = WS_BIG + 224 * MiB, B_KVN = WS_BIG + 240 * MiB, B_KR = WS_BIG + 248 * MiB;
constexpr size_t B_OCAT0 = WS_BIG;
constexpr size_t HE_QM = WS_H, HE_KM = WS_H + 48 * MiB, HE_VTM = WS_H + 96 * MiB;
constexpr size_t B_SQ = WS_BIG + 96 * MiB, B_SK = WS_BIG + 160 * MiB, B_SVT = WS_BIG + 176 * MiB, B_OCAT1 = WS_BIG + 192 * MiB;
constexpr size_t B_ACT = WS_BIG;

__device__ __forceinline__ unsigned cvt_pk_bf16(float lo, float hi) { unsigned r; asm volatile("v_cvt_pk_bf16_f32 %0, %1, %2" : "=v"(r) : "v"(lo), "v"(hi)); return r; }
__device__ __forceinline__ float bf2f(unsigned short b) { return __uint_as_float(((unsigned)b) << 16); }
__device__ __forceinline__ float bflo(unsigned w) { return __uint_as_float(w << 16); }
__device__ __forceinline__ float bfhi(unsigned w) { return __uint_as_float(w & 0xffff0000u); }
__device__ __forceinline__ unsigned short f2bf(float f) { return (unsigned short)(cvt_pk_bf16(f, 0.f) & 0xffffu); }
__device__ __forceinline__ float wave_sum(float v) {
#pragma unroll
    for (int o = 1; o < 64; o <<= 1) v += __shfl_xor(v, o);
    return v;
}
template <int W> __device__ __forceinline__ float group_sum(float v) {
#pragma unroll
    for (int o = 1; o < W; o <<= 1) v += __shfl_xor(v, o);
    return v;
}
__device__ __forceinline__ int tok_pos(int tok) { return tok < 8192 ? (tok & 4095) : (tok & 2047); }


#define XB_TMO      128
#define XB_XCNT(j)  (256  + 64 * (j))
#define XB_XSUB(j)  (1280 + 64 * (j))
#define XB_XGEN(j)  (2304 + 64 * (j))
#define XB_TOP      3328
#define XB_TOPGEN   3392
#define XCD_BAR_WORDS 3456
#define XB_SPIN_CAP (1u << 18)
__device__ __forceinline__ unsigned xb_ld(unsigned* p)              { return __hip_atomic_load(p, __ATOMIC_RELAXED, __HIP_MEMORY_SCOPE_AGENT); }
__device__ __forceinline__ unsigned xb_add(unsigned* p, unsigned v) { return __hip_atomic_fetch_add(p, v, __ATOMIC_RELAXED, __HIP_MEMORY_SCOPE_AGENT); }
__device__ __forceinline__ unsigned xb_xcc_id() { return (unsigned)__builtin_amdgcn_s_getreg((3 << 11) | 20) & 0xFu; }
#define XB_SPIN(cond, bar) do { unsigned _sp = 0; while (cond) { __builtin_amdgcn_s_sleep(1); \
    if ((++_sp & 255u) == 0u) { if (xb_ld(&(bar)[XB_TMO])) break; if (_sp > XB_SPIN_CAP) { atomicAdd(&(bar)[XB_TMO], 1u); break; } } } } while (0)
struct XcdBarrier { unsigned* bar; unsigned x; volatile LAS unsigned* st; };
__device__ __forceinline__ XcdBarrier xcd_barrier_post(unsigned* bar, volatile LAS unsigned* st) {
    XcdBarrier b; b.bar = bar; b.x = xb_xcc_id(); b.st = st;
    if (threadIdx.x == 0) (void)xb_add(&bar[XB_XCNT(b.x)], 1u);
    return b;
}
__device__ __forceinline__ void xcd_barrier_complete(unsigned* bar, unsigned x, unsigned& nloc, unsigned& nx) {
    const unsigned G = gridDim.x * gridDim.y * gridDim.z;
    unsigned sum, cnt, mine, sp = 0u;
    for (;;) {
        sum = 0u; cnt = 0u; mine = 0u;
#pragma unroll
        for (unsigned j = 0; j < 16; ++j) { const unsigned c = xb_ld(&bar[XB_XCNT(j)]); sum += c; cnt += (c > 0u) ? 1u : 0u; mine = (j == x) ? c : mine; }
        if (sum == G) break;
        __builtin_amdgcn_s_sleep(1);
        if ((++sp & 255u) == 0u) { if (xb_ld(&bar[XB_TMO])) break; if (sp > XB_SPIN_CAP) { atomicAdd(&bar[XB_TMO], 1u); break; } }
    }
    nloc = mine > 0u ? mine : 1u; nx = cnt > 0u ? cnt : 1u;
}
__device__ __forceinline__ void xcd_barrier(const XcdBarrier& b) {
    asm volatile("s_waitcnt vmcnt(0)" ::: "memory");
    __syncthreads();
    if (threadIdx.x == 0) {
        unsigned* bar = b.bar;
        __builtin_amdgcn_s_waitcnt(0);
        unsigned nloc = b.st[0], nx = b.st[1];
        if (nloc == 0u) { xcd_barrier_complete(bar, b.x, nloc, nx); b.st[0] = nloc; b.st[1] = nx; }
        const unsigned old = xb_add(&bar[XB_XSUB(b.x)], 1u);
        const unsigned gen = old / nloc;
        if (old + 1u == (gen + 1u) * nloc) {
            __builtin_amdgcn_fence(__ATOMIC_RELEASE, "agent");
            asm volatile("s_waitcnt vmcnt(0)" ::: "memory");
            const unsigned og = xb_add(&bar[XB_TOP], 1u);
            const unsigned tg = og / nx;
            if (og + 1u == (tg + 1u) * nx) xb_add(&bar[XB_TOPGEN], 1u);
            else XB_SPIN(xb_ld(&bar[XB_TOPGEN]) == tg, bar);
            __builtin_amdgcn_fence(__ATOMIC_ACQUIRE, "agent");
            xb_add(&bar[XB_XGEN(b.x)], 1u);
            asm volatile("s_waitcnt vmcnt(0)" ::: "memory");
        } else {
            XB_SPIN(xb_ld(&bar[XB_XGEN(b.x)]) == gen, bar);
            __builtin_amdgcn_fence(__ATOMIC_ACQUIRE, "agent");
            asm volatile("s_waitcnt vmcnt(0)" ::: "memory");
        }
    }
    __syncthreads();
}

namespace pg8 {
constexpr int BM = 256, BK = 64, HALF = 128, HTB = HALF * BK * 2, STAGE_BYTES = 8 * HTB, NXCD = 8, WGM = 8;
__device__ __forceinline__ int lds_byte(int r, int c) { const int st = (r >> 4) * 2 + (c >> 5), rr = r & 15, cc = c & 31, ob = rr * 64 + cc * 2; return st * 1024 + (ob ^ (((ob >> 9) & 1) << 5)); }
__device__ __forceinline__ void stage_rc(int b, int& R, int& C) { const int st = b / 1024, sb = b % 1024, swz = sb ^ (((sb >> 9) & 1) << 5); R = (st >> 1) * 16 + swz / 64; C = (st & 1) * 32 + (swz % 64) / 2; }
__device__ __forceinline__ int perm32(int rho) { const int n = rho >> 4, i = rho & 15; return 8 * (i >> 2) + 4 * n + (i & 3); }

struct Unit { int pm, pn; };
struct Gemm { const bf16_t* A; const bf16_t* Bt; int M, N, K; };
struct StaticOrder {
    int nM, nN, nwg, G, c, ioff, icnt;
    __device__ void init(int M_, int N_, int G_, int c_, int ioff_ = 0, int icnt_ = 1 << 20) { nM = M_ / BM; nN = N_ / BM; nwg = nM * nN; G = G_; c = c_; ioff = ioff_; icnt = icnt_; }
    __device__ bool next(int i, Unit& u) const {
        if (i >= icnt) return false;
        const long L = (long)(i + ioff) * G + c; if (L >= nwg) return false;
        int wgid = (int)L; { const int q = nwg / NXCD, r = nwg % NXCD, xcd = wgid % NXCD, off = wgid / NXCD; wgid = (xcd < r ? xcd * (q + 1) : r * (q + 1) + (xcd - r) * q) + off; }
        const int nig = WGM * nN, gid = wgid / nig, fm = gid * WGM, gsz = (nM - fm) < WGM ? (nM - fm) : WGM;
        u.pm = fm + ((wgid % nig) % gsz); u.pn = (wgid % nig) / gsz; return true;
    }
};

__device__ __forceinline__ unsigned dpp_ror8(unsigned x) { return (unsigned)__builtin_amdgcn_update_dpp(0, (int)x, 0x128, 0xf, 0xf, false); }
__device__ __forceinline__ void store_pair_lines(bf16_t* O, int ldc, int row, int fr, int col0, u32x4 wA, u32x4 wB) {
    const u32x4 sA = {dpp_ror8(wA.x), dpp_ror8(wA.y), dpp_ror8(wA.z), dpp_ror8(wA.w)}, sB = {dpp_ror8(wB.x), dpp_ror8(wB.y), dpp_ror8(wB.z), dpp_ror8(wB.w)};
    const bool lo = fr < 8;
    const u32x4 o1 = lo ? wA : sB, o2 = lo ? sA : wB;
    const int r1 = row - fr + (fr & 7), cb = col0 + (lo ? 0 : 8);
    *(u32x4*)(O + (size_t)r1 * ldc + cb) = o1;
    *(u32x4*)(O + (size_t)(r1 + 8) * ldc + cb) = o2;
}
__device__ __forceinline__ void load_pair_lines(const bf16_t* P, int ld, int row, int fr, int col0, u32x4& wA, u32x4& wB, int boff = 8) {
    const bool lo = fr < 8;
    const int r1 = row - fr + (fr & 7), cb = col0 + (lo ? 0 : boff);
    const u32x4 l1 = *(const u32x4*)(P + (size_t)r1 * ld + cb), l2 = *(const u32x4*)(P + (size_t)(r1 + 8) * ld + cb);
    const u32x4 s1 = {dpp_ror8(l1.x), dpp_ror8(l1.y), dpp_ror8(l1.z), dpp_ror8(l1.w)}, s2 = {dpp_ror8(l2.x), dpp_ror8(l2.y), dpp_ror8(l2.z), dpp_ror8(l2.w)};
    wA = lo ? l1 : s2; wB = lo ? s1 : l2;
}
template <int ACT  > struct EpiBf16 {
    static constexpr bool PERM = true, F32OUT = false;
    bf16_t* O; int ldc;
    const float* ssin;
    float* ssout;
    __device__ __forceinline__ void operator()(const f32x4 (&acc)[2][2][4][2], const Unit& u, int wr, int wc, int fr, int fq) const {
        const int row0 = u.pm * BM + wr * 64 + fr; const int col0 = u.pn * BM + wc * 64 + 16 * fq;
#pragma unroll
        for (int ai = 0; ai < 2; ++ai)
#pragma unroll
            for (int m = 0; m < 4; ++m) { const int row = row0 + ai * HALF + m * 16;
                const float rs = ssin ? __builtin_amdgcn_rsqf(ssin[row] * (1.f / D) + EPS) : 1.0f; float sq = 0.f; u32x4 w[2];
#pragma unroll
                for (int bj = 0; bj < 2; ++bj) { f32x4 v0 = acc[ai][bj][m][0] * rs, v1 = acc[ai][bj][m][1] * rs;
                    if (ACT == 1) {
#pragma unroll
                        for (int j = 0; j < 4; ++j) { const float a = fmaxf(v0[j], 0.f), b = fmaxf(v1[j], 0.f); v0[j] = a * a; v1[j] = b * b; } }
                    sq += (v0[0] * v0[0] + v0[1] * v0[1]) + (v0[2] * v0[2] + v0[3] * v0[3]) + (v1[0] * v1[0] + v1[1] * v1[1]) + (v1[2] * v1[2] + v1[3] * v1[3]);
                    w[bj].x = cvt_pk_bf16(v0[0], v0[1]); w[bj].y = cvt_pk_bf16(v0[2], v0[3]); w[bj].z = cvt_pk_bf16(v1[0], v1[1]); w[bj].w = cvt_pk_bf16(v1[2], v1[3]); }
                store_pair_lines(O, ldc, row, fr, col0, w[0], w[1]);
                if (ssout) { sq += __shfl_xor(sq, 16); sq += __shfl_xor(sq, 32); if (fq == 0) unsafeAtomicAdd(ssout + row, sq); } }
    }
};
struct EpiResid {
    static constexpr bool PERM = false, F32OUT = false;
    float* X; bf16_t* XB; float* ssout;
    const float* rsin;
    const float* src_p; const float* src_s;
    __device__ __forceinline__ void operator()(const f32x4 (&acc)[2][2][4][2], const Unit& u, int wr, int wc, int fr, int fq) const {
        const int row0 = u.pm * BM + wr * 64 + fr, col0 = u.pn * BM + wc * 32 + 4 * fq;
#pragma unroll
        for (int ai = 0; ai < 2; ++ai)
#pragma unroll
            for (int m = 0; m < 4; ++m) { const int row = row0 + ai * HALF + m * 16; const size_t off = (size_t)row * D + col0; float sq = 0.f;
                const float sc = rsin ? __builtin_amdgcn_rcpf(rsin[row] * (1.f / D) + EPS) : 1.0f;
                const float* rp = src_p ? (row < 8192 ? src_p + off : src_s + (off - (size_t)8192 * D)) : X + off;
#pragma unroll
                for (int bj = 0; bj < 2; ++bj)
#pragma unroll
                    for (int n = 0; n < 2; ++n) { const f32x4 o = *(const f32x4*)(rp + bj * HALF + n * 16) + acc[ai][bj][m][n] * sc; *(f32x4*)(X + off + bj * HALF + n * 16) = o;
                        sq += (o[0] * o[0] + o[1] * o[1]) + (o[2] * o[2] + o[3] * o[3]);
                        u32x2 w; w.x = cvt_pk_bf16(o[0], o[1]); w.y = cvt_pk_bf16(o[2], o[3]); *(u32x2*)(XB + off + bj * HALF + n * 16) = w; }
                if (ssout) { sq += __shfl_xor(sq, 16); sq += __shfl_xor(sq, 32); if (fq == 0) unsafeAtomicAdd(ssout + row, sq); } }
    }
};
struct EpiGate {
    static constexpr bool PERM = false, F32OUT = false;
    float* X; const bf16_t* E; const float* sse; const float* g; bf16_t* XB; float* ssout;
    __device__ __forceinline__ void operator()(const f32x4 (&acc)[2][2][4][2], const Unit& u, int wr, int wc, int fr, int fq) const {
        const int row0 = u.pm * BM + wr * 64 + fr, col0 = u.pn * BM + wc * 32 + 4 * fq;
        f32x4 gv[2][2];
#pragma unroll
        for (int bj = 0; bj < 2; ++bj)
#pragma unroll
            for (int n = 0; n < 2; ++n) gv[bj][n] = *(const f32x4*)(g + col0 + bj * HALF + n * 16);
#pragma unroll
        for (int ai = 0; ai < 2; ++ai)
#pragma unroll
            for (int m = 0; m < 4; ++m) { const int row = row0 + ai * HALF + m * 16; const size_t off = (size_t)row * D + col0; const float ri = __builtin_amdgcn_rsqf(sse[row] * (1.f / D) + EPS); float sq = 0.f;
#pragma unroll
                for (int bj = 0; bj < 2; ++bj)
#pragma unroll
                    for (int n = 0; n < 2; ++n) { float* p = X + off + bj * HALF + n * 16; const u32x2 ew = *(const u32x2*)(E + off + bj * HALF + n * 16);
                        const f32x4 a = acc[ai][bj][m][n]; const f32x4 gg = gv[bj][n]; f32x4 o = *(const f32x4*)p;
                        const float e0 = bflo(ew.x), e1 = bfhi(ew.x), e2 = bflo(ew.y), e3 = bfhi(ew.y);
                        o[0] += e0 * ri * gg[0] * __builtin_amdgcn_rcpf(1.f + __builtin_amdgcn_exp2f(-a[0] * LOG2E));
                        o[1] += e1 * ri * gg[1] * __builtin_amdgcn_rcpf(1.f + __builtin_amdgcn_exp2f(-a[1] * LOG2E));
                        o[2] += e2 * ri * gg[2] * __builtin_amdgcn_rcpf(1.f + __builtin_amdgcn_exp2f(-a[2] * LOG2E));
                        o[3] += e3 * ri * gg[3] * __builtin_amdgcn_rcpf(1.f + __builtin_amdgcn_exp2f(-a[3] * LOG2E));
                        *(f32x4*)p = o;
                        if (XB) { sq += (o[0] * o[0] + o[1] * o[1]) + (o[2] * o[2] + o[3] * o[3]);
                            u32x2 w; w.x = cvt_pk_bf16(o[0], o[1]); w.y = cvt_pk_bf16(o[2], o[3]); *(u32x2*)(XB + off + bj * HALF + n * 16) = w; } }
                if (XB) { sq += __shfl_xor(sq, 16); sq += __shfl_xor(sq, 32); if (fq == 0) unsafeAtomicAdd(ssout + row, sq); } }
    }
};

struct EpiResidB {
    static constexpr bool PERM = true, F32OUT = false;
    const bf16_t* R;
    const float* src_p; const float* src_s;
    bf16_t* O;
    float* ssout;
    const float* rsin;
    __device__ __forceinline__ void operator()(const f32x4 (&acc)[2][2][4][2], const Unit& u, int wr, int wc, int fr, int fq) const {
        const int row0 = u.pm * BM + wr * 64 + fr, col0 = u.pn * BM + wc * 64 + 16 * fq;
#pragma unroll
        for (int ai = 0; ai < 2; ++ai)
#pragma unroll
            for (int m = 0; m < 4; ++m) { const int row = row0 + ai * HALF + m * 16; const size_t off = (size_t)row * D + col0; float sq = 0.f; u32x4 w[2];
                const float sc = rsin ? __builtin_amdgcn_rcpf(rsin[row] * (1.f / D) + EPS) : 1.0f;
                u32x4 rr[2]; if (R) load_pair_lines(R, D, row, fr, col0, rr[0], rr[1]);
#pragma unroll
                for (int bj = 0; bj < 2; ++bj) { f32x4 r0, r1;
                    if (R) { const u32x4 rw = rr[bj]; r0 = (f32x4){bflo(rw.x), bfhi(rw.x), bflo(rw.y), bfhi(rw.y)}; r1 = (f32x4){bflo(rw.z), bfhi(rw.z), bflo(rw.w), bfhi(rw.w)}; }
                    else { const float* rp = (row < 8192 ? src_p + off : src_s + (off - (size_t)8192 * D)) + 8 * bj; r0 = *(const f32x4*)rp; r1 = *(const f32x4*)(rp + 4); }
                    const f32x4 o0 = r0 + acc[ai][bj][m][0] * sc, o1 = r1 + acc[ai][bj][m][1] * sc;
                    sq += (o0[0] * o0[0] + o0[1] * o0[1]) + (o0[2] * o0[2] + o0[3] * o0[3]) + (o1[0] * o1[0] + o1[1] * o1[1]) + (o1[2] * o1[2] + o1[3] * o1[3]);
                    w[bj].x = cvt_pk_bf16(o0[0], o0[1]); w[bj].y = cvt_pk_bf16(o0[2], o0[3]); w[bj].z = cvt_pk_bf16(o1[0], o1[1]); w[bj].w = cvt_pk_bf16(o1[2], o1[3]); }
                store_pair_lines(O, D, row, fr, col0, w[0], w[1]);
                if (ssout) { sq += __shfl_xor(sq, 16); sq += __shfl_xor(sq, 32); if (fq == 0) unsafeAtomicAdd(ssout + row, sq); } }
    }
};
struct EpiGateB {
    static constexpr bool PERM = true, F32OUT = false;
    const bf16_t* R; const bf16_t* E; const float* sse; const float* g; bf16_t* O; float* ssout; float* OUT;
    __device__ __forceinline__ void operator()(const f32x4 (&acc)[2][2][4][2], const Unit& u, int wr, int wc, int fr, int fq) const {
        const int row0 = u.pm * BM + wr * 64 + fr, col0 = u.pn * BM + wc * 64 + 16 * fq;
        f32x4 gv[2][2];
#pragma unroll
        for (int bj = 0; bj < 2; ++bj) { gv[bj][0] = *(const f32x4*)(g + col0 + 8 * bj); gv[bj][1] = *(const f32x4*)(g + col0 + 8 * bj + 4); }
#pragma unroll
        for (int ai = 0; ai < 2; ++ai)
#pragma unroll
            for (int m = 0; m < 4; ++m) { const int row = row0 + ai * HALF + m * 16; const size_t off = (size_t)row * D + col0; const float ri = __builtin_amdgcn_rsqf(sse[row] * (1.f / D) + EPS); float sq = 0.f; u32x4 w[2];
                u32x4 rr[2], ee[2]; load_pair_lines(R, D, row, fr, col0, rr[0], rr[1]); load_pair_lines(E, D, row, fr, col0, ee[0], ee[1]);
#pragma unroll
                for (int bj = 0; bj < 2; ++bj) { const u32x4 rw = rr[bj], ew = ee[bj];
                    const float r[8] = {bflo(rw.x), bfhi(rw.x), bflo(rw.y), bfhi(rw.y), bflo(rw.z), bfhi(rw.z), bflo(rw.w), bfhi(rw.w)};
                    const float e[8] = {bflo(ew.x), bfhi(ew.x), bflo(ew.y), bfhi(ew.y), bflo(ew.z), bfhi(ew.z), bflo(ew.w), bfhi(ew.w)};
                    float o[8];
#pragma unroll
                    for (int j = 0; j < 8; ++j) { const float a = acc[ai][bj][m][j >> 2][j & 3]; const float gg = gv[bj][j >> 2][j & 3];
                        o[j] = r[j] + e[j] * ri * gg * __builtin_amdgcn_rcpf(1.f + __builtin_amdgcn_exp2f(-a * LOG2E)); }
                    if (OUT) { *(f32x4*)(OUT + off + 8 * bj) = (f32x4){o[0], o[1], o[2], o[3]}; *(f32x4*)(OUT + off + 8 * bj + 4) = (f32x4){o[4], o[5], o[6], o[7]}; }
                    else { sq += (o[0] * o[0] + o[1] * o[1]) + (o[2] * o[2] + o[3] * o[3]) + (o[4] * o[4] + o[5] * o[5]) + (o[6] * o[6] + o[7] * o[7]);
                        w[bj].x = cvt_pk_bf16(o[0], o[1]); w[bj].y = cvt_pk_bf16(o[2], o[3]); w[bj].z = cvt_pk_bf16(o[4], o[5]); w[bj].w = cvt_pk_bf16(o[6], o[7]); } }
                if (!OUT) { store_pair_lines(O, D, row, fr, col0, w[0], w[1]);
                    sq += __shfl_xor(sq, 16); sq += __shfl_xor(sq, 32); if (fq == 0) unsafeAtomicAdd(ssout + row, sq); } }
    }
};

struct EpiGateF32 {
    static constexpr bool PERM = true, F32OUT = true;
    const bf16_t* R; const bf16_t* E; const float* sse; const float* g; float* OUT;
    __device__ __forceinline__ void operator()(const f32x4 (&acc)[2][2][4][2], const Unit& u, int wr, int wc, int fr, int fq) const {
        const int row0 = u.pm * BM + wr * 64 + fr, col0 = u.pn * BM + wc * 64 + 8 * fq;
        f32x4 gv[2][2];
#pragma unroll
        for (int bj = 0; bj < 2; ++bj) { gv[bj][0] = *(const f32x4*)(g + col0 + 32 * bj); gv[bj][1] = *(const f32x4*)(g + col0 + 32 * bj + 4); }
        const bool lo = fr < 8;
#pragma unroll
        for (int ai = 0; ai < 2; ++ai)
#pragma unroll
            for (int m = 0; m < 4; ++m) { const int row = row0 + ai * HALF + m * 16; const float ri = __builtin_amdgcn_rsqf(sse[row] * (1.f / D) + EPS);
                u32x4 rr[2], ee[2]; load_pair_lines(R, D, row, fr, col0, rr[0], rr[1], 32); load_pair_lines(E, D, row, fr, col0, ee[0], ee[1], 32);
                float* orow = OUT + (size_t)(row - fr + (fr & 7)) * D + col0 + (lo ? 0 : 4);
#pragma unroll
                for (int bj = 0; bj < 2; ++bj) { const u32x4 rw = rr[bj], ew = ee[bj];
                    const float r[8] = {bflo(rw.x), bfhi(rw.x), bflo(rw.y), bfhi(rw.y), bflo(rw.z), bfhi(rw.z), bflo(rw.w), bfhi(rw.w)};
                    const float e[8] = {bflo(ew.x), bfhi(ew.x), bflo(ew.y), bfhi(ew.y), bflo(ew.z), bfhi(ew.z), bflo(ew.w), bfhi(ew.w)};
                    float o[8];
#pragma unroll
                    for (int j = 0; j < 8; ++j) { const float a = acc[ai][bj][m][j >> 2][j & 3]; const float gg = gv[bj][j >> 2][j & 3];
                        o[j] = r[j] + e[j] * ri * gg * __builtin_amdgcn_rcpf(1.f + __builtin_amdgcn_exp2f(-a * LOG2E)); }
                    f32x4 o1, o2;
#pragma unroll
                    for (int j = 0; j < 4; ++j) { const unsigned a = __float_as_uint(o[j]), b = __float_as_uint(o[4 + j]); const unsigned sa = dpp_ror8(a), sb = dpp_ror8(b);
                        o1[j] = __uint_as_float(lo ? a : sb); o2[j] = __uint_as_float(lo ? sa : b); }
                    *(f32x4*)(orow + 32 * bj) = o1; *(f32x4*)(orow + (size_t)8 * D + 32 * bj) = o2; } }
    }
};

template <class Epi>
__device__ __forceinline__ void gemm_phase(LAS unsigned char* lds, const Gemm g, const StaticOrder& S, const Epi& E) {
    int tid = threadIdx.x; asm volatile("" : "+v"(tid));
    const int wid = __builtin_amdgcn_readfirstlane(tid >> 6), lane = tid & 63, wr = wid >> 2, wc = wid & 3, fr = lane & 15, fq = lane >> 4;
    const int K = g.K, nt = K / BK;
    unsigned voffA[2], voffB0[2], voffB1[2];
#pragma unroll
    for (int i = 0; i < 2; ++i) { int R, C; stage_rc(tid * 16 + i * 8192, R, C);
        const int Rw = 64 * (R >> 5) + 16 * ((R >> 2) & 3) + 4 * ((R >> 4) & 1) + (R & 3);
        const int Rf = 64 * (R >> 5) + 8 * ((R >> 2) & 3) + 4 * ((R >> 4) & 1) + (R & 3);
        const int Rb0 = Epi::PERM ? (Epi::F32OUT ? Rf : Rw) : R, Rb1 = Epi::PERM ? (Epi::F32OUT ? Rf + 32 : Rw + 8) : R + HALF;
        voffA[i] = (unsigned)(R * K + C) * 2u; voffB0[i] = (unsigned)(Rb0 * K + C) * 2u; voffB1[i] = (unsigned)(Rb1 * K + C) * 2u; }
    const size_t kstep = (size_t)(BK * 2);
    const size_t hstep = (size_t)HALF * K * 2;
    const size_t tstep = 2 * hstep;
    const unsigned ldsw = (unsigned)wid * 1024u;
    const int aoff = lds_byte(wr * 64 + fr, fq * 8), boff = lds_byte(wc * 32 + fr, fq * 8);
#define PG8_SA(b, h) (((b) * 2 + (h)) * HTB)
#define PG8_SB(b, h) ((4 + (b) * 2 + (h)) * HTB)
#define PG8_STAGE(bufoff, gbase, voff) do { _Pragma("unroll") for (int _i = 0; _i < 2; ++_i) \
        __builtin_amdgcn_global_load_lds((const unsigned*)((const char*)(gbase) + (voff)[_i]), (LAS unsigned*)(lds + (bufoff) + ldsw + _i * 8192), 16, 0, 0); } while (0)
#define PG8_LDA(dst, b, h) do { _Pragma("unroll") for (int m = 0; m < 4; ++m) _Pragma("unroll") for (int k = 0; k < 2; ++k) dst[m][k] = *(const LAS bf16x8*)(lds + PG8_SA(b, h) + aoff + m * 2048 + k * 1024); } while (0)
#define PG8_LDB(dst, b, h) do { _Pragma("unroll") for (int n = 0; n < 2; ++n) _Pragma("unroll") for (int k = 0; k < 2; ++k) dst[n][k] = *(const LAS bf16x8*)(lds + PG8_SB(b, h) + boff + n * 2048 + k * 1024); } while (0)
#define PG8_MMA(ai, bj, At, Bt) do { __builtin_amdgcn_s_setprio(1); _Pragma("unroll") for (int m = 0; m < 4; ++m) _Pragma("unroll") for (int n = 0; n < 2; ++n) _Pragma("unroll") for (int k = 0; k < 2; ++k) \
        acc[ai][bj][m][n] = __builtin_amdgcn_mfma_f32_16x16x32_bf16(Bt[n][k], At[m][k], acc[ai][bj][m][n], 0, 0, 0); __builtin_amdgcn_s_setprio(0); } while (0)
#define PG8_WAIT_V(n) asm volatile("s_waitcnt vmcnt(" #n ")" ::: "memory")
#define PG8_WAIT_L(n) asm volatile("s_waitcnt lgkmcnt(" #n ")" ::: "memory")
#define PG8_BAR __builtin_amdgcn_s_barrier()
#define PG8_SCHED __builtin_amdgcn_sched_barrier(0)
    Unit cur, nxt; int ui = 0;
    if (!S.next(0, cur)) return;
    f32x4 acc[2][2][4][2];
#pragma unroll
    for (int a = 0; a < 2; ++a)
#pragma unroll
        for (int b = 0; b < 2; ++b)
#pragma unroll
            for (int m = 0; m < 4; ++m)
#pragma unroll
                for (int n = 0; n < 2; ++n) acc[a][b][m][n] = (f32x4){0.f, 0.f, 0.f, 0.f};
    bf16x8 At[4][2], B0[2][2], B1[2][2];
    const char* cA = (const char*)g.A + (size_t)cur.pm * tstep; const char* cB = (const char*)g.Bt + (size_t)cur.pn * tstep;
    PG8_STAGE(PG8_SB(0, 0), cB, voffB0); PG8_STAGE(PG8_SA(0, 0), cA, voffA); PG8_STAGE(PG8_SB(0, 1), cB, voffB1); PG8_STAGE(PG8_SA(0, 1), cA + hstep, voffA);
    if (wr == 1) PG8_BAR;
    PG8_WAIT_V(4); PG8_BAR;
    PG8_STAGE(PG8_SB(1, 0), cB + kstep, voffB0); PG8_STAGE(PG8_SA(1, 0), cA + kstep, voffA); PG8_STAGE(PG8_SB(1, 1), cB + kstep, voffB1);
    PG8_WAIT_V(6); PG8_BAR;
    for (;;) {
        const bool has_next = S.next(ui + 1, nxt);
        const char* nA = has_next ? (const char*)g.A + (size_t)nxt.pm * tstep : cA; const char* nB = has_next ? (const char*)g.Bt + (size_t)nxt.pn * tstep : cB;
        for (int t = 0; t < nt; t += 2) {
            const bool last = (t == nt - 2);
            const char* a1 = cA + (size_t)(t + 1) * kstep;
            const char* a2 = last ? nA : cA + (size_t)(t + 2) * kstep; const char* b2 = last ? nB : cB + (size_t)(t + 2) * kstep;
            const char* a3 = a2 + kstep; const char* b3 = b2 + kstep;
            PG8_LDB(B0, 0, 0); PG8_SCHED; PG8_LDA(At, 0, 0); PG8_STAGE(PG8_SA(1, 1), a1 + hstep, voffA);
            PG8_WAIT_L(8); PG8_BAR; PG8_WAIT_L(0); PG8_MMA(0, 0, At, B0); PG8_BAR; PG8_SCHED;
            PG8_LDB(B1, 0, 1); PG8_STAGE(PG8_SB(0, 0), b2, voffB0);
            PG8_BAR; PG8_WAIT_L(0); PG8_MMA(0, 1, At, B1); PG8_BAR;
            PG8_LDA(At, 0, 1); PG8_STAGE(PG8_SA(0, 0), a2, voffA);
            PG8_BAR; PG8_WAIT_L(0); PG8_MMA(1, 0, At, B0); PG8_BAR; PG8_SCHED;
            PG8_STAGE(PG8_SB(0, 1), b2, voffB1);
            PG8_WAIT_V(6); PG8_BAR; PG8_MMA(1, 1, At, B1); PG8_BAR;
            PG8_LDB(B0, 1, 0); PG8_SCHED; PG8_LDA(At, 1, 0); PG8_STAGE(PG8_SA(0, 1), a2 + hstep, voffA);
            PG8_WAIT_L(8); PG8_BAR; PG8_WAIT_L(0); PG8_MMA(0, 0, At, B0); PG8_BAR; PG8_SCHED;
            PG8_LDB(B1, 1, 1); PG8_STAGE(PG8_SB(1, 0), b3, voffB0);
            PG8_BAR; PG8_WAIT_L(0); PG8_MMA(0, 1, At, B1); PG8_BAR;
            PG8_LDA(At, 1, 1); PG8_STAGE(PG8_SA(1, 0), a3, voffA);
            PG8_BAR; PG8_WAIT_L(0); PG8_MMA(1, 0, At, B0); PG8_BAR; PG8_SCHED;
            PG8_STAGE(PG8_SB(1, 1), b3, voffB1);
            PG8_WAIT_V(6); PG8_BAR; PG8_MMA(1, 1, At, B1); PG8_BAR;
        }
        E(acc, cur, wr, wc, fr, fq);
        if (!has_next) break;
#pragma unroll
        for (int a = 0; a < 2; ++a)
#pragma unroll
            for (int b = 0; b < 2; ++b)
#pragma unroll
                for (int m = 0; m < 4; ++m)
#pragma unroll
                    for (int n = 0; n < 2; ++n) acc[a][b][m][n] = (f32x4){0.f, 0.f, 0.f, 0.f};
        cur = nxt; cA = nA; cB = nB; ++ui;
    }
    PG8_WAIT_V(0);
    if (wr == 0) PG8_BAR;
    PG8_BAR;
#undef PG8_SA
#undef PG8_SB
#undef PG8_STAGE
#undef PG8_LDA
#undef PG8_LDB
#undef PG8_MMA
#undef PG8_WAIT_V
#undef PG8_WAIT_L
#undef PG8_BAR
#undef PG8_SCHED
}
template <class Epi>
__device__ __forceinline__ void run_gemm(LAS unsigned char* lds, const bf16_t* A, const bf16_t* Bt, int N, int K, const Epi& E, int ioff = 0, int icnt = 1 << 20) {
    Gemm g{A, Bt, M, N, K}; StaticOrder S; S.init(M, N, (int)gridDim.x, (int)blockIdx.x, ioff, icnt);
    gemm_phase<Epi>(lds, g, S, E);
    __syncthreads();
}
}

__device__ __forceinline__ void transpose_item(const float* W, int K, int N, bf16_t* WT, LAS float* scr, int item, int lane, const float* gk) {
    const int nblk = N / 64, kb = item / nblk, nb = item % nblk, k0 = 64 * kb, n0 = 64 * nb;
    f32x4 v[16];
#pragma unroll
    for (int i = 0; i < 16; ++i) { const int kk = 4 * i + (lane >> 4); v[i] = *(const f32x4*)(W + (size_t)(k0 + kk) * N + n0 + 4 * (lane & 15)); }
    if (gk) {
#pragma unroll
        for (int i = 0; i < 16; ++i) v[i] *= gk[k0 + 4 * i + (lane >> 4)]; }
#pragma unroll
    for (int i = 0; i < 16; ++i) { LAS float* d = scr + (4 * i + (lane >> 4)) * 65 + 4 * (lane & 15); d[0] = v[i][0]; d[1] = v[i][1]; d[2] = v[i][2]; d[3] = v[i][3]; }
    asm volatile("s_waitcnt lgkmcnt(0)" ::: "memory");
    const int c = lane & 7;
#pragma unroll
    for (int j = 0; j < 8; ++j) { const int n = (lane >> 3) + 8 * j; const LAS float* s = scr + (8 * c) * 65 + n;
        u32x4 o; o.x = cvt_pk_bf16(s[0 * 65], s[1 * 65]); o.y = cvt_pk_bf16(s[2 * 65], s[3 * 65]); o.z = cvt_pk_bf16(s[4 * 65], s[5 * 65]); o.w = cvt_pk_bf16(s[6 * 65], s[7 * 65]);
        *(u32x4*)(WT + (size_t)(n0 + n) * K + k0 + 8 * c) = o; }
    asm volatile("s_waitcnt lgkmcnt(0)" ::: "memory");
}
__device__ __forceinline__ void convert_matrix(const float* W, int K, int N, bf16_t* WT, LAS float* scr, int gw, int ngw, int lane, const float* gk = nullptr) {
    const int nitems = (K / 64) * (N / 64);
    for (int it = gw; it < nitems; it += ngw) transpose_item(W, K, N, WT, scr, it, lane, gk);
}

__device__ __forceinline__ void norm_row(const float* xrow, const float* g, bf16_t* orow, float* xcopy, int lane) {
    f32x4 v[8]; float s = 0.f;
#pragma unroll
    for (int j = 0; j < 4; ++j) { v[2 * j] = ((const f32x4*)xrow)[2 * (lane + 64 * j)]; v[2 * j + 1] = ((const f32x4*)xrow)[2 * (lane + 64 * j) + 1]; }
#pragma unroll
    for (int j = 0; j < 8; ++j) s += (v[j][0] * v[j][0] + v[j][1] * v[j][1]) + (v[j][2] * v[j][2] + v[j][3] * v[j][3]);
    if (xcopy) {
#pragma unroll
        for (int j = 0; j < 4; ++j) { ((f32x4*)xcopy)[2 * (lane + 64 * j)] = v[2 * j]; ((f32x4*)xcopy)[2 * (lane + 64 * j) + 1] = v[2 * j + 1]; } }
    const float rinv = 1.0f / sqrtf(wave_sum(s) * (1.f / D) + EPS);
#pragma unroll
    for (int j = 0; j < 4; ++j) { const f32x4 g0 = ((const f32x4*)g)[2 * (lane + 64 * j)], g1 = ((const f32x4*)g)[2 * (lane + 64 * j) + 1]; const f32x4 a = v[2 * j], c = v[2 * j + 1];
        u32x4 w; w.x = cvt_pk_bf16(a[0] * rinv * g0[0], a[1] * rinv * g0[1]); w.y = cvt_pk_bf16(a[2] * rinv * g0[2], a[3] * rinv * g0[3]);
        w.z = cvt_pk_bf16(c[0] * rinv * g1[0], c[1] * rinv * g1[1]); w.w = cvt_pk_bf16(c[2] * rinv * g1[2], c[3] * rinv * g1[3]);
        ((u32x4*)orow)[lane + 64 * j] = w; }
}
__device__ __forceinline__ float rinv_row_bf16(const bf16_t* erow, int lane) {
    float s = 0.f;
#pragma unroll
    for (int j = 0; j < 4; ++j) { const u32x4 w = ((const u32x4*)erow)[lane + 64 * j];
        const float a0 = bflo(w.x), a1 = bfhi(w.x), a2 = bflo(w.y), a3 = bfhi(w.y), a4 = bflo(w.z), a5 = bfhi(w.z), a6 = bflo(w.w), a7 = bfhi(w.w);
        s += (a0 * a0 + a1 * a1) + (a2 * a2 + a3 * a3) + (a4 * a4 + a5 * a5) + (a6 * a6 + a7 * a7); }
    return 1.0f / sqrtf(wave_sum(s) * (1.f / D) + EPS);
}
__device__ __forceinline__ void conv_p_row(const float* prow, bf16_t* orow, int lane) {
    const f32x4 v = ((const f32x4*)prow)[lane]; u32x2 w; w.x = cvt_pk_bf16(v[0], v[1]); w.y = cvt_pk_bf16(v[2], v[3]); ((u32x2*)orow)[lane] = w;
}

__device__ __forceinline__ void vt_item(LAS unsigned char* lds, const bf16_t* src, int sstride, bf16_t* vt_rows, int tok0) {
    int tid = threadIdx.x; asm volatile("" : "+v"(tid));
    constexpr int TROW = 272;
#pragma unroll
    for (int i = 0; i < 2; ++i) { const int cid = tid + i * 512, row = cid >> 4, cc = cid & 15;
        const u32x4 v = *(const u32x4*)(src + (size_t)row * sstride + cc * 8);
        *(LAS u32x4*)(lds + row * TROW + cc * 16) = v; }
    __syncthreads();
#pragma unroll
    for (int i = 0; i < 2; ++i) { const int wid2 = tid + i * 512, d = wid2 >> 3, ck = wid2 & 7;
        unsigned short e[8];
#pragma unroll
        for (int j = 0; j < 8; ++j) { const int quad = (ck & 1) * 2 + (j >> 2); const int q2 = (quad == 1) ? 2 : (quad == 2 ? 1 : quad); const int t = (ck >> 1) * 16 + q2 * 4 + (j & 3);
            e[j] = *(const LAS unsigned short*)(lds + t * TROW + d * 2); }
        u32x4 o; o.x = e[0] | ((unsigned)e[1] << 16); o.y = e[2] | ((unsigned)e[3] << 16); o.z = e[4] | ((unsigned)e[5] << 16); o.w = e[6] | ((unsigned)e[7] << 16);
        *(u32x4*)(vt_rows + (size_t)d * M + tok0 + ck * 8) = o; }
    __syncthreads();
}

__device__ __forceinline__ int crow(int r, int hi) { return (r & 3) + 8 * (r >> 2) + 4 * hi; }
template <int DQK> struct AG { static constexpr int KROW = DQK * 2 + 16, KBUF = 64 * KROW, VROW = 144, VBUF = 128 * VROW, VOFF = 2 * KBUF, KC = (64 * DQK / 8) / 512, RPB_OFF = 2 * KBUF + 3 * VBUF; };

template <int DQK, int MODE>
__device__ __forceinline__ void attn_unit(LAS unsigned char* lds, const bf16_t* qptr, const bf16_t* kbase, int kstride, const bf16_t* vtbase,
                                          int tile_lo, int tile_hi, int wlo, int whi, int a0  , int a1  ,
                                          float m_init, float l_init, bf16_t* optr) {
    typedef AG<DQK> G;
    int tid = threadIdx.x; asm volatile("" : "+v"(tid));
    const int lane = tid & 63, r32 = lane & 31, hh = lane >> 5;
    bf16x8 qf[DQK / 16];
#pragma unroll
    for (int dc = 0; dc < DQK / 16; ++dc) qf[dc] = *(const bf16x8*)(qptr + dc * 16 + hh * 8);
    f32x16 O[4];
#pragma unroll
    for (int i = 0; i < 4; ++i)
#pragma unroll
        for (int j = 0; j < 16; ++j) O[i][j] = 0.f;
    float m = m_init, l = l_init;
    const int nt = tile_hi - tile_lo;
    u32x4 kreg[G::KC], vreg[2];
    int krow_[G::KC], kcc_[G::KC];
#pragma unroll
    for (int i = 0; i < G::KC; ++i) { const int cid = tid + i * 512; krow_[i] = cid / (DQK / 8); kcc_[i] = cid % (DQK / 8); }
#define ATT_LOAD(tile) do { const size_t key0 = (size_t)(tile) * 64; \
        _Pragma("unroll") for (int i = 0; i < G::KC; ++i) kreg[i] = *(const u32x4*)(kbase + (key0 + krow_[i]) * kstride + kcc_[i] * 8); \
        _Pragma("unroll") for (int i = 0; i < 2; ++i) { const int cid = tid + i * 512; vreg[i] = *(const u32x4*)(vtbase + (size_t)(cid >> 3) * M + key0 + (cid & 7) * 8); } } while (0)
#define ATT_WRITE(kslot, vslot) do { LAS unsigned char* kb_ = lds + (kslot) * G::KBUF; LAS unsigned char* vb_ = lds + G::VOFF + (vslot) * G::VBUF; \
        _Pragma("unroll") for (int i = 0; i < G::KC; ++i) *(LAS u32x4*)(kb_ + krow_[i] * G::KROW + kcc_[i] * 16) = kreg[i]; \
        _Pragma("unroll") for (int i = 0; i < 2; ++i) { const int cid = tid + i * 512; *(LAS u32x4*)(vb_ + (cid >> 3) * G::VROW + (cid & 7) * 16) = vreg[i]; } } while (0)
#define ATT_PV(vslot) do { const LAS unsigned char* vb = lds + G::VOFF + (vslot) * G::VBUF; \
        _Pragma("unroll") for (int db = 0; db < 4; ++db) _Pragma("unroll") for (int ks = 0; ks < 4; ++ks) { \
            const bf16x8 va = *(const LAS bf16x8*)(vb + (db * 32 + r32) * G::VROW + ks * 32 + hh * 16); \
            O[db] = __builtin_amdgcn_mfma_f32_32x32x16_bf16(va, pf[ks], O[db], 0, 0, 0); } } while (0)
    const bool late = __builtin_amdgcn_readfirstlane(tid >> 6) >= 4;
    bf16x8 pf[4]; bool have_pf = false; int vprev = 0;
#pragma unroll
    for (int i = 0; i < 4; ++i) pf[i] = (bf16x8){0, 0, 0, 0, 0, 0, 0, 0};
    ATT_LOAD(tile_lo); ATT_WRITE(0, 0);
    __syncthreads();
    int vcur = 0;
    for (int it = 0; it < nt; ++it) {
        const int tile = tile_lo + it, buf = it & 1;
        const int vnext = (vcur == 2) ? 0 : vcur + 1;
        if (it + 1 < nt) ATT_LOAD(tile + 1);
        if (late && have_pf) { ATT_PV(vprev); have_pf = false; }
        if (tile >= wlo && tile < whi) {
            const LAS unsigned char* kb = lds + buf * G::KBUF;
            f32x16 S0, S1;
#pragma unroll
            for (int j = 0; j < 16; ++j) { S0[j] = 0.f; S1[j] = 0.f; }
#pragma unroll
            for (int dc = 0; dc < DQK / 16; ++dc) {
                const bf16x8 ka = *(const LAS bf16x8*)(kb + r32 * G::KROW + dc * 32 + hh * 16);
                const bf16x8 kb2 = *(const LAS bf16x8*)(kb + (32 + r32) * G::KROW + dc * 32 + hh * 16);
                S0 = __builtin_amdgcn_mfma_f32_32x32x16_bf16(ka, qf[dc], S0, 0, 0, 0);
                S1 = __builtin_amdgcn_mfma_f32_32x32x16_bf16(kb2, qf[dc], S1, 0, 0, 0);
            }
            if (MODE == 1) {
                const LAS float* rpbL = (const LAS float*)(lds + G::RPB_OFF);
                const int c = a0; int cs = c - 8; cs = cs < 0 ? 0 : (cs > 48 ? 48 : cs);
                const LAS float* rrow = rpbL + (tile + a1) * 31;
                int cb = 4 * hh + 15 - c, vb_ = 4 * hh - cs; asm volatile("" : "+v"(cb), "+v"(vb_));
                float bb0[16], bb1[16];
#pragma unroll
                for (int j = 0; j < 16; ++j) {
                    const int kk = (j & 3) + 8 * (j >> 2);
                    int i0 = kk + cb; i0 = i0 < 0 ? 0 : (i0 > 30 ? 30 : i0); int i1 = kk + 32 + cb; i1 = i1 < 0 ? 0 : (i1 > 30 ? 30 : i1);
                    bb0[j] = rrow[i0]; bb1[j] = rrow[i1];
                }
#pragma unroll
                for (int j = 0; j < 16; ++j) asm volatile("" : "+v"(bb0[j]), "+v"(bb1[j]));
#pragma unroll
                for (int j = 0; j < 16; ++j) {
                    const int kk = (j & 3) + 8 * (j >> 2);
                    S0[j] = ((unsigned)(kk + vb_) < 16u) ? S0[j] + bb0[j] : -INFINITY;
                    S1[j] = ((unsigned)(kk + 32 + vb_) < 16u) ? S1[j] + bb1[j] : -INFINITY;
                }
            }
            if (MODE == 2) {
                const int dbase = tile * 64 - a0;
#pragma unroll
                for (int j = 0; j < 16; ++j) {
                    const int d0 = dbase + crow(j, hh), d1 = d0 + 32;
                    S0[j] = (d0 >= -128 && d0 <= 128) ? S0[j] : -INFINITY;
                    S1[j] = (d1 >= -128 && d1 <= 128) ? S1[j] : -INFINITY;
                }
            }
            float pmax = S0[0];
#pragma unroll
            for (int j = 1; j < 16; ++j) pmax = fmaxf(pmax, S0[j]);
#pragma unroll
            for (int j = 0; j < 16; ++j) pmax = fmaxf(pmax, S1[j]);
            { auto rr = __builtin_amdgcn_permlane32_swap(__float_as_uint(pmax), __float_as_uint(pmax), false, false); pmax = fmaxf(__uint_as_float(rr[0]), __uint_as_float(rr[1])); }
            if (!__all(pmax - m <= 8.0f)) {
                const float mn2 = fmaxf(m, pmax); const float alpha = __builtin_amdgcn_exp2f(m - mn2); m = mn2; l *= alpha;
#pragma unroll
                for (int i = 0; i < 4; ++i)
#pragma unroll
                    for (int j = 0; j < 16; ++j) O[i][j] *= alpha;
            }
            const float mn = m;
            float ps = 0.f;
#pragma unroll
            for (int j = 0; j < 16; ++j) { S0[j] = __builtin_amdgcn_exp2f(S0[j] - mn); S1[j] = __builtin_amdgcn_exp2f(S1[j] - mn); ps += S0[j] + S1[j]; }
            l += ps;
            { u32x4 w;
              w.x = cvt_pk_bf16(S0[0], S0[1]); w.y = cvt_pk_bf16(S0[2], S0[3]); w.z = cvt_pk_bf16(S0[4], S0[5]); w.w = cvt_pk_bf16(S0[6], S0[7]); pf[0] = *(bf16x8*)&w;
              w.x = cvt_pk_bf16(S0[8], S0[9]); w.y = cvt_pk_bf16(S0[10], S0[11]); w.z = cvt_pk_bf16(S0[12], S0[13]); w.w = cvt_pk_bf16(S0[14], S0[15]); pf[1] = *(bf16x8*)&w;
              w.x = cvt_pk_bf16(S1[0], S1[1]); w.y = cvt_pk_bf16(S1[2], S1[3]); w.z = cvt_pk_bf16(S1[4], S1[5]); w.w = cvt_pk_bf16(S1[6], S1[7]); pf[2] = *(bf16x8*)&w;
              w.x = cvt_pk_bf16(S1[8], S1[9]); w.y = cvt_pk_bf16(S1[10], S1[11]); w.z = cvt_pk_bf16(S1[12], S1[13]); w.w = cvt_pk_bf16(S1[14], S1[15]); pf[3] = *(bf16x8*)&w; }
            if (!late) ATT_PV(vcur); else { have_pf = true; vprev = vcur; }
        }
        if (it + 1 < nt) ATT_WRITE(buf ^ 1, vnext);
        vcur = vnext;
        __syncthreads();
    }
    if (late && have_pf) ATT_PV(vprev);
#undef ATT_LOAD
#undef ATT_WRITE
#undef ATT_PV
    { auto rr = __builtin_amdgcn_permlane32_swap(__float_as_uint(l), __float_as_uint(l), false, false); l = __uint_as_float(rr[0]) + __uint_as_float(rr[1]); }
    const float inv = 1.0f / l;
#pragma unroll
    for (int db = 0; db < 4; ++db)
#pragma unroll
        for (int t = 0; t < 2; ++t) {
            const unsigned x0 = cvt_pk_bf16(O[db][8 * t + 0] * inv, O[db][8 * t + 1] * inv), x1 = cvt_pk_bf16(O[db][8 * t + 2] * inv, O[db][8 * t + 3] * inv);
            const unsigned y0 = cvt_pk_bf16(O[db][8 * t + 4] * inv, O[db][8 * t + 5] * inv), y1 = cvt_pk_bf16(O[db][8 * t + 6] * inv, O[db][8 * t + 7] * inv);
            auto r0 = __builtin_amdgcn_permlane32_swap(x0, y0, false, false); auto r1 = __builtin_amdgcn_permlane32_swap(x1, y1, false, false);
            u32x4 w = {r0[0], r1[0], r0[1], r1[1]};
            *(u32x4*)(optr + db * 32 + 16 * t + 8 * hh) = w;
        }
    __syncthreads();
}

__global__ void __launch_bounds__(NTHREADS, 2) fwd_megakernel(Params P) {
    extern __shared__ __attribute__((aligned(16))) unsigned char lds_raw[];
    LAS unsigned char* lds = (LAS unsigned char*)lds_raw;
    cg::grid_group grid = cg::this_grid();
    if (threadIdx.x < 4) ((LAS unsigned*)(lds + LDS_BYTES - 16))[threadIdx.x] = 0u;
    __syncthreads();
    XcdBarrier xbar;
    { KARG(kpb); xbar = xcd_barrier_post((unsigned*)(kpb->ws + WS_BAR), (volatile LAS unsigned*)(lds + LDS_BYTES - 16)); }
#define GRID_SYNC() xcd_barrier(xbar)
    { KARG(kpc); if (kpc->ws == nullptr) grid.sync(); }
#define PHASE_VARS \
    KARG(kp); unsigned char* ws = kp->ws; float* X = kp->out; \
    int tid = threadIdx.x; asm volatile("" : "+v"(tid)); const int lane = tid & 63, wave = __builtin_amdgcn_readfirstlane(tid >> 6); \
    int bid = blockIdx.x; asm volatile("" : "+s"(bid)); const int G = gridDim.x; const int gw = bid * NWAVES + wave, ngw = G * NWAVES; \
    bf16_t* H = (bf16_t*)(ws + WS_H); bf16_t* E = (bf16_t*)(ws + WS_E); bf16_t* PB = (bf16_t*)(ws + WS_PB); \
    float* SS = (float*)(ws + WS_SS); float* ROPE64 = (float*)(ws + WS_ROPE64); float* ROPE128 = (float*)(ws + WS_ROPE128); \
    LAS float* scr = (LAS float*)(lds + wave * 16640); \
    (void)X; (void)H; (void)E; (void)PB; (void)SS; (void)ROPE64; (void)ROPE128; (void)scr; (void)gw; (void)ngw; (void)lane; (void)G

    if (PH(0)) {
        PHASE_VARS;
        _Pragma("unroll 1") for (int rep_ = 0; rep_ < REP_CONV; ++rep_) {
        convert_matrix(kp->in[I_PLE_PROJ], 256, D, (bf16_t*)(ws + W_PROJ), scr, gw, ngw, lane);
        convert_matrix(kp->in[I_EV_WIN], D, EV_IN, (bf16_t*)(ws + W_EVIN), scr, gw, ngw, lane);
        convert_matrix(kp->in[I_WQB], 512, 1536, (bf16_t*)(ws + W_QB), scr, gw, ngw, lane);
        convert_matrix(kp->in[I_WKVB], 256, 2048, (bf16_t*)(ws + W_KVB), scr, gw, ngw, lane);
        convert_matrix(kp->in[I_EV_WOUT], D, D, (bf16_t*)(ws + W_EVOUT), scr, gw, ngw, lane);
        }
        for (int i = bid * NTHREADS + tid; i < 4096 * 32; i += G * NTHREADS) { const int pos = i >> 5, f = i & 31;
            const float inv = exp2f(-(float)(2 * f) / 64.0f * 13.287712379549449f);
            double rev = (double)pos * (double)inv * 0.15915494309189535; rev -= floor(rev);
            ROPE64[i] = __builtin_amdgcn_cosf((float)rev); ROPE64[4096 * 32 + i] = __builtin_amdgcn_sinf((float)rev); }
        for (int i = bid * NTHREADS + tid; i < 4096 * 64; i += G * NTHREADS) { const int pos = i >> 6, f = i & 63;
            const float inv = exp2f(-(float)(2 * f) / 128.0f * 13.287712379549449f);
            double rev = (double)pos * (double)inv * 0.15915494309189535; rev -= floor(rev);
            ROPE128[i] = __builtin_amdgcn_cosf((float)rev); ROPE128[4096 * 64 + i] = __builtin_amdgcn_sinf((float)rev); }
        _Pragma("unroll 1") for (int rp_ = 0; rp_ < REP_PREP; ++rp_) for (int row = gw; row < M; row += ngw) {
            const float* xr = row < 8192 ? kp->in[I_XP] + (size_t)row * D : kp->in[I_XS] + (size_t)(row - 8192) * D;
            norm_row(xr, kp->in[I_ATTN_NORM], H + (size_t)row * D, nullptr, lane);
            const float* pr = row < 8192 ? kp->in[I_PP] + (size_t)row * 256 : kp->in[I_PS] + (size_t)(row - 8192) * 256;
            conv_p_row(pr, PB + (size_t)row * 256, lane);
            conv_p_row(pr + (size_t)8192 * 256, (bf16_t*)(ws + WS_PB1) + (size_t)row * 256, lane);
        }
        for (int i = bid * NTHREADS + tid; i < 5 * M; i += G * NTHREADS) SS[i] = 0.f;
    }
    GRID_SYNC();

    if (PH(1)) { PHASE_VARS; pg8::EpiBf16<0> Ep{(bf16_t*)(ws + B_Z), EV_INP, nullptr, nullptr}; pg8::run_gemm(lds, H, (const bf16_t*)(ws + W_EVIN), EV_INP, D, Ep); }
    GRID_SYNC();

    if (PH(2)) {
        PHASE_VARS;
        const bf16_t* Z = (const bf16_t*)(ws + B_Z);
        bf16_t* QN = (bf16_t*)(ws + B_QN); bf16_t* KVN = (bf16_t*)(ws + B_KVN); bf16_t* KR = (bf16_t*)(ws + B_KR);
        bf16_t* NQ = (bf16_t*)(ws + B_NQ); bf16_t* NK = (bf16_t*)(ws + B_NK); bf16_t* NVT = (bf16_t*)(ws + B_NVT);
        const float CNA = 0.08838834764831845f * LOG2E;
        _Pragma("unroll 1") for (int rp_ = 0; rp_ < REP_PREP; ++rp_) for (int tok = gw; tok < M; tok += ngw) {
            const bf16_t* z = Z + (size_t)tok * EV_INP; const int pos = tok_pos(tok);
            { const u32x4 w = *(const u32x4*)(z + 8 * lane);
              float v[8] = {bflo(w.x), bfhi(w.x), bflo(w.y), bfhi(w.y), bflo(w.z), bfhi(w.z), bflo(w.w), bfhi(w.w)}; float s = 0.f;
#pragma unroll
              for (int j = 0; j < 8; ++j) s += v[j] * v[j];
              const float ri = 1.0f / sqrtf(wave_sum(s) * (1.f / 512.f) + EPS); const float* g = kp->in[I_QA_NORM] + 8 * lane;
              u32x4 o; o.x = cvt_pk_bf16(v[0] * ri * g[0], v[1] * ri * g[1]); o.y = cvt_pk_bf16(v[2] * ri * g[2], v[3] * ri * g[3]); o.z = cvt_pk_bf16(v[4] * ri * g[4], v[5] * ri * g[5]); o.w = cvt_pk_bf16(v[6] * ri * g[6], v[7] * ri * g[7]);
              *(u32x4*)(QN + (size_t)tok * 512 + 8 * lane) = o; }
            { const u32x2 w = *(const u32x2*)(z + 512 + 4 * lane);
              float v[4] = {bflo(w.x), bfhi(w.x), bflo(w.y), bfhi(w.y)}; const float s = (v[0] * v[0] + v[1] * v[1]) + (v[2] * v[2] + v[3] * v[3]);
              const float ri = 1.0f / sqrtf(wave_sum(s) * (1.f / 256.f) + EPS); const float* g = kp->in[I_KVA_NORM] + 4 * lane;
              u32x2 o; o.x = cvt_pk_bf16(v[0] * ri * g[0], v[1] * ri * g[1]); o.y = cvt_pk_bf16(v[2] * ri * g[2], v[3] * ri * g[3]);
              *(u32x2*)(KVN + (size_t)tok * 256 + 4 * lane) = o; }
            { const float v = bf2f(z[768 + lane]); const float ri = 1.0f / sqrtf(wave_sum(v * v) * (1.f / 64.f) + EPS);
              const float y = v * ri * kp->in[I_KROPE_NORM][lane]; const float yp = __shfl_xor(y, 32);
              const float c = ROPE64[pos * 32 + (lane & 31)], s = ROPE64[4096 * 32 + pos * 32 + (lane & 31)];
              const float o = lane < 32 ? y * c - yp * s : y * c + yp * s;
              KR[(size_t)tok * 64 + lane] = f2bf(o); }
#pragma unroll
            for (int p = 0; p < 2; ++p) {
                const int d0 = 8 * (lane & 15);
                { const u32x4 w = *(const u32x4*)(z + 832 + p * 512 + 8 * lane);
                  float v[8] = {bflo(w.x), bfhi(w.x), bflo(w.y), bfhi(w.y), bflo(w.z), bfhi(w.z), bflo(w.w), bfhi(w.w)}; float s = 0.f;
#pragma unroll
                  for (int j = 0; j < 8; ++j) s += v[j] * v[j];
                  const float ri = CNA / sqrtf(group_sum<16>(s) * (1.f / 128.f) + EPS); const float* g = kp->in[I_NAQ_NORM] + d0;
                  u32x4 o; o.x = cvt_pk_bf16(v[0] * ri * g[0], v[1] * ri * g[1]); o.y = cvt_pk_bf16(v[2] * ri * g[2], v[3] * ri * g[3]); o.z = cvt_pk_bf16(v[4] * ri * g[4], v[5] * ri * g[5]); o.w = cvt_pk_bf16(v[6] * ri * g[6], v[7] * ri * g[7]);
                  *(u32x4*)(NQ + (size_t)tok * 1024 + p * 512 + 8 * lane) = o; }
                { const u32x4 w = *(const u32x4*)(z + 1856 + p * 512 + 8 * lane);
                  float v[8] = {bflo(w.x), bfhi(w.x), bflo(w.y), bfhi(w.y), bflo(w.z), bfhi(w.z), bflo(w.w), bfhi(w.w)}; float s = 0.f;
#pragma unroll
                  for (int j = 0; j < 8; ++j) s += v[j] * v[j];
                  const float ri = 1.0f / sqrtf(group_sum<16>(s) * (1.f / 128.f) + EPS); const float* g = kp->in[I_NAK_NORM] + d0;
                  u32x4 o; o.x = cvt_pk_bf16(v[0] * ri * g[0], v[1] * ri * g[1]); o.y = cvt_pk_bf16(v[2] * ri * g[2], v[3] * ri * g[3]); o.z = cvt_pk_bf16(v[4] * ri * g[4], v[5] * ri * g[5]); o.w = cvt_pk_bf16(v[6] * ri * g[6], v[7] * ri * g[7]);
                  *(u32x4*)(NK + (size_t)tok * 1024 + p * 512 + 8 * lane) = o; }
            }
        }
        __syncthreads();
        _Pragma("unroll 1") for (int rp_ = 0; rp_ < REP_PREP; ++rp_) for (int it = bid; it < 256 * 8; it += G) { const int tt = it >> 3, h = it & 7;
            vt_item(lds, Z + (size_t)(tt * 64) * EV_INP + 2880 + h * 128, EV_INP, NVT + (size_t)(h * 128) * M, tt * 64); }
    }
    GRID_SYNC();

    if (PH(3)) { PHASE_VARS; pg8::EpiBf16<0> Ep{(bf16_t*)(ws + B_Q1), 1536, nullptr, nullptr}; pg8::run_gemm(lds, (const bf16_t*)(ws + B_QN), (const bf16_t*)(ws + W_QB), 1536, 512, Ep); }
    if (PH(3)) { PHASE_VARS; pg8::EpiBf16<0> Ep{(bf16_t*)(ws + B_KV1), 2048, nullptr, nullptr}; pg8::run_gemm(lds, (const bf16_t*)(ws + B_KVN), (const bf16_t*)(ws + W_KVB), 2048, 256, Ep); }
    GRID_SYNC();

    if (PH(4)) {
        PHASE_VARS;
        const bf16_t* Q1 = (const bf16_t*)(ws + B_Q1); const bf16_t* KV1 = (const bf16_t*)(ws + B_KV1); const bf16_t* KR = (const bf16_t*)(ws + B_KR);
        bf16_t* QM = (bf16_t*)(ws + HE_QM); bf16_t* KM = (bf16_t*)(ws + HE_KM); bf16_t* VTM = (bf16_t*)(ws + HE_VTM);
        const float CM = 0.07216878364870323f * LOG2E;
        const int hq = lane >> 3, sl = lane & 7;
        float gqn[16], gkn[16], gqr[8];
#pragma unroll
        for (int j = 0; j < 16; ++j) { gqn[j] = kp->in[I_QNOPE_NORM][sl * 16 + j]; gkn[j] = kp->in[I_KNOPE_NORM][sl * 16 + j]; }
#pragma unroll
        for (int j = 0; j < 8; ++j) gqr[j] = kp->in[I_QROPE_NORM][sl * 8 + j];
        _Pragma("unroll 1") for (int rp_ = 0; rp_ < REP_PREP; ++rp_) for (int tok = gw; tok < M; tok += ngw) {
            const int pos = tok_pos(tok);
            const bf16_t* q = Q1 + (size_t)tok * 1536 + hq * 192; bf16_t* qo = QM + (size_t)tok * 1536 + hq * 192;
            const bf16_t* k = KV1 + (size_t)tok * 2048 + hq * 256; bf16_t* ko = KM + (size_t)tok * 1536 + hq * 192;
            const u32x4 qa = *(const u32x4*)(q + sl * 16), qb = *(const u32x4*)(q + sl * 16 + 8), qr = *(const u32x4*)(q + 128 + sl * 8);
            const u32x4 ka = *(const u32x4*)(k + sl * 16), kb = *(const u32x4*)(k + sl * 16 + 8), krv = *(const u32x4*)(KR + (size_t)tok * 64 + sl * 8);
            const f32x4 c0 = *(const f32x4*)(ROPE64 + pos * 32 + (sl & 3) * 8), c1 = *(const f32x4*)(ROPE64 + pos * 32 + (sl & 3) * 8 + 4);
            const f32x4 s0 = *(const f32x4*)(ROPE64 + 4096 * 32 + pos * 32 + (sl & 3) * 8), s1 = *(const f32x4*)(ROPE64 + 4096 * 32 + pos * 32 + (sl & 3) * 8 + 4);
            { float v[16] = {bflo(qa.x), bfhi(qa.x), bflo(qa.y), bfhi(qa.y), bflo(qa.z), bfhi(qa.z), bflo(qa.w), bfhi(qa.w), bflo(qb.x), bfhi(qb.x), bflo(qb.y), bfhi(qb.y), bflo(qb.z), bfhi(qb.z), bflo(qb.w), bfhi(qb.w)};
              float ss = 0.f;
#pragma unroll
              for (int j = 0; j < 16; ++j) ss += v[j] * v[j];
              const float ri = CM / sqrtf(group_sum<8>(ss) * (1.f / 128.f) + EPS);
              u32x4 o0, o1;
              o0.x = cvt_pk_bf16(v[0] * ri * gqn[0], v[1] * ri * gqn[1]); o0.y = cvt_pk_bf16(v[2] * ri * gqn[2], v[3] * ri * gqn[3]); o0.z = cvt_pk_bf16(v[4] * ri * gqn[4], v[5] * ri * gqn[5]); o0.w = cvt_pk_bf16(v[6] * ri * gqn[6], v[7] * ri * gqn[7]);
              o1.x = cvt_pk_bf16(v[8] * ri * gqn[8], v[9] * ri * gqn[9]); o1.y = cvt_pk_bf16(v[10] * ri * gqn[10], v[11] * ri * gqn[11]); o1.z = cvt_pk_bf16(v[12] * ri * gqn[12], v[13] * ri * gqn[13]); o1.w = cvt_pk_bf16(v[14] * ri * gqn[14], v[15] * ri * gqn[15]);
              *(u32x4*)(qo + sl * 16) = o0; *(u32x4*)(qo + sl * 16 + 8) = o1; }
            { float v[8] = {bflo(qr.x), bfhi(qr.x), bflo(qr.y), bfhi(qr.y), bflo(qr.z), bfhi(qr.z), bflo(qr.w), bfhi(qr.w)};
              const float cc[8] = {c0[0], c0[1], c0[2], c0[3], c1[0], c1[1], c1[2], c1[3]}, sn[8] = {s0[0], s0[1], s0[2], s0[3], s1[0], s1[1], s1[2], s1[3]};
              float ss = 0.f;
#pragma unroll
              for (int j = 0; j < 8; ++j) ss += v[j] * v[j];
              const float ri = 1.0f / sqrtf(group_sum<8>(ss) * (1.f / 64.f) + EPS);
              float o[8];
#pragma unroll
              for (int j = 0; j < 8; ++j) { const float y = v[j] * ri * gqr[j]; const float yp = __shfl_xor(y, 4); o[j] = (sl < 4 ? y * cc[j] - yp * sn[j] : y * cc[j] + yp * sn[j]) * CM; }
              u32x4 w; w.x = cvt_pk_bf16(o[0], o[1]); w.y = cvt_pk_bf16(o[2], o[3]); w.z = cvt_pk_bf16(o[4], o[5]); w.w = cvt_pk_bf16(o[6], o[7]);
              *(u32x4*)(qo + 128 + sl * 8) = w; }
            { float v[16] = {bflo(ka.x), bfhi(ka.x), bflo(ka.y), bfhi(ka.y), bflo(ka.z), bfhi(ka.z), bflo(ka.w), bfhi(ka.w), bflo(kb.x), bfhi(kb.x), bflo(kb.y), bfhi(kb.y), bflo(kb.z), bfhi(kb.z), bflo(kb.w), bfhi(kb.w)};
              float ss = 0.f;
#pragma unroll
              for (int j = 0; j < 16; ++j) ss += v[j] * v[j];
              const float ri = 1.0f / sqrtf(group_sum<8>(ss) * (1.f / 128.f) + EPS);
              u32x4 o0, o1;
              o0.x = cvt_pk_bf16(v[0] * ri * gkn[0], v[1] * ri * gkn[1]); o0.y = cvt_pk_bf16(v[2] * ri * gkn[2], v[3] * ri * gkn[3]); o0.z = cvt_pk_bf16(v[4] * ri * gkn[4], v[5] * ri * gkn[5]); o0.w = cvt_pk_bf16(v[6] * ri * gkn[6], v[7] * ri * gkn[7]);
              o1.x = cvt_pk_bf16(v[8] * ri * gkn[8], v[9] * ri * gkn[9]); o1.y = cvt_pk_bf16(v[10] * ri * gkn[10], v[11] * ri * gkn[11]); o1.z = cvt_pk_bf16(v[12] * ri * gkn[12], v[13] * ri * gkn[13]); o1.w = cvt_pk_bf16(v[14] * ri * gkn[14], v[15] * ri * gkn[15]);
              *(u32x4*)(ko + sl * 16) = o0; *(u32x4*)(ko + sl * 16 + 8) = o1; }
            *(u32x4*)(ko + 128 + sl * 8) = krv;
        }
        __syncthreads();
        _Pragma("unroll 1") for (int rp_ = 0; rp_ < REP_PREP; ++rp_) for (int it = bid; it < 256 * 8; it += G) { const int tt = it >> 3, h = it & 7;
            vt_item(lds, KV1 + (size_t)(tt * 64) * 2048 + h * 256 + 128, 2048, VTM + (size_t)(h * 128) * M, tt * 64); }
    }
    GRID_SYNC();

    if (PH(5)) {
        PHASE_VARS;
        const bf16_t* QM = (const bf16_t*)(ws + HE_QM); const bf16_t* KM = (const bf16_t*)(ws + HE_KM); const bf16_t* VTM = (const bf16_t*)(ws + HE_VTM);
        const bf16_t* NQ = (const bf16_t*)(ws + B_NQ); const bf16_t* NK = (const bf16_t*)(ws + B_NK); const bf16_t* NVT = (const bf16_t*)(ws + B_NVT);
        bf16_t* OC = (bf16_t*)(ws + B_OCAT0);
        const int cslot = (G == 256) ? ((bid >> 3) % 5) : 0; int aunit = 0;
#define A1_CONV() do { if (aunit == cslot) { __syncthreads(); \
            convert_matrix(kp->in[I_WUP], D, DFF, (bf16_t*)(ws + W_UP), scr, gw, ngw, lane, kp->in[I_MLP_NORM]); \
            convert_matrix(kp->in[I_WDOWN], DFF, D, (bf16_t*)(ws + W_DOWN), scr, gw, ngw, lane); \
            convert_matrix(kp->in[I_PLE_GATE], D, D, (bf16_t*)(ws + W_GATE), scr, gw, ngw, lane); \
            __syncthreads(); } ++aunit; } while (0)
        _Pragma("unroll 1") for (int rep_ = 0; rep_ < REP_MLA; ++rep_)
        for (int u = bid; u < 512; u += G) {
            A1_CONV();
            int seqbase, T, h, qb;
            int uu = u; if (G == 256) { const int b = u & 255, x = b & 7, j = b >> 3; uu = (u < 256) ? (x * 2 + (j >> 4)) * 16 + (j & 15) : 256 + (x * 4 + (j >> 3)) * 8 + (j & 7); }
            if (uu < 256) { const int s = uu >> 7; seqbase = s * 4096; T = 4096; h = (uu >> 4) & 7; qb = uu & 15; }
            else { const int v = uu - 256; const int s = v >> 6; seqbase = 8192 + s * 2048; T = 2048; h = (v >> 3) & 7; qb = v & 7; }
            const int tq = seqbase + qb * 256 + wave * 32 + (lane & 31);
            const int t0 = seqbase >> 6, t1 = (seqbase + T) >> 6;
            attn_unit<192, 0>(lds, QM + (size_t)tq * 1536 + h * 192, KM + h * 192, 1536, VTM + (size_t)(h * 128) * M, t0, t1, t0, t1, 0, 0, -1e30f, 0.f, OC + (size_t)tq * 2048 + h * 128);
        }
        _Pragma("unroll 1") for (int rep_ = 0; rep_ < REP_NA; ++rep_)
        for (int u = bid; u < 512; u += G) {
            A1_CONV();
            int seqbase, rows, h, rg;
            int uu = u; if (G == 256) { const int b = u & 255, x = b & 7, j = b >> 3; uu = (u < 256) ? (x * 2 + (j >> 4)) * 16 + (j & 15) : 256 + (x * 4 + (j >> 3)) * 8 + (j & 7); }
            if (uu < 256) { const int s = uu >> 7; seqbase = s * 4096; rows = 64; h = (uu >> 4) & 7; rg = uu & 15; }
            else { const int v = uu - 256; const int s = v >> 6; seqbase = 8192 + s * 2048; rows = 32; h = (v >> 3) & 7; rg = v & 7; }
            { LAS float* rpbL = (LAS float*)(lds + AG<128>::RPB_OFF); for (int i = tid; i < 465; i += NTHREADS) rpbL[i] = kp->in[I_RPB][h * 465 + i] * LOG2E; }
            const int r = rg * 4 + (wave >> 1), c = (wave & 1) * 32 + (lane & 31);
            const int tq = seqbase + r * 64 + c;
            const int st0 = seqbase >> 6;
            int rs_lo = rg * 4 - 4; rs_lo = rs_lo < 0 ? 0 : (rs_lo > rows - 8 ? rows - 8 : rs_lo);
            int rs_hi = rg * 4 + 3 - 4; rs_hi = rs_hi < 0 ? 0 : (rs_hi > rows - 8 ? rows - 8 : rs_hi);
            int rs = r - 4; rs = rs < 0 ? 0 : (rs > rows - 8 ? rows - 8 : rs);
            attn_unit<128, 1>(lds, NQ + (size_t)tq * 1024 + h * 128, NK + h * 128, 1024, NVT + (size_t)(h * 128) * M, st0 + rs_lo, st0 + rs_hi + 8, st0 + rs, st0 + rs + 8, c, 7 - r - st0, -1e30f, 0.f,
                              OC + (size_t)tq * 2048 + 1024 + h * 128);
        }
        if (aunit <= cslot) { aunit = cslot; A1_CONV(); }
#undef A1_CONV
    }
    GRID_SYNC();

    if (PH(6)) { PHASE_VARS; pg8::EpiResidB Ep{nullptr, kp->in[I_XP], kp->in[I_XS], H, SS + 0 * M, nullptr}; pg8::run_gemm(lds, (const bf16_t*)(ws + B_OCAT0), (const bf16_t*)(ws + W_EVOUT), D, D, Ep); }
    if (PH(6)) { PHASE_VARS; pg8::EpiBf16<0> Ep{E, D, nullptr, SS + 3 * M}; pg8::run_gemm(lds, PB, (const bf16_t*)(ws + W_PROJ), D, 256, Ep); }
    GRID_SYNC();

    if (PH(9)) { PHASE_VARS; pg8::EpiBf16<1> Ep{(bf16_t*)(ws + B_ACT), DFF, nullptr, nullptr};
        const int ksp = (G == 256) ? ((bid >> 3) & 7) : (1 << 20);
        pg8::run_gemm(lds, H, (const bf16_t*)(ws + W_UP), DFF, D, Ep, 0, ksp);
        convert_matrix(kp->in[I_OD_WIN], D, OD_IN, (bf16_t*)(ws + W_ODIN), scr, gw, ngw, lane, kp->in[I_ATTN_NORM] + D);
        convert_matrix(kp->in[I_OD_WOUT], D, D, (bf16_t*)(ws + W_ODOUT), scr, gw, ngw, lane);
        convert_matrix(kp->in[I_PLE_GATE] + (size_t)D * D, D, D, (bf16_t*)(ws + W_GATE1), scr, gw, ngw, lane);
        convert_matrix(kp->in[I_PLE_PROJ] + (size_t)256 * D, 256, D, (bf16_t*)(ws + W_PROJ), scr, gw, ngw, lane);
        __syncthreads();
        pg8::run_gemm(lds, H, (const bf16_t*)(ws + W_UP), DFF, D, Ep, ksp, 1 << 20); }
    GRID_SYNC();
    if (PH(10)) { PHASE_VARS; pg8::EpiResidB Ep{H, nullptr, nullptr, (bf16_t*)X, nullptr, SS + 0 * M};
        const int ksp = (G == 256) ? ((bid >> 3) % 3) : (1 << 20);
        pg8::run_gemm(lds, (const bf16_t*)(ws + B_ACT), (const bf16_t*)(ws + W_DOWN), D, DFF, Ep, 0, ksp);
        convert_matrix(kp->in[I_WUP] + (size_t)D * DFF, D, DFF, (bf16_t*)(ws + W_UP), scr, gw, ngw, lane, kp->in[I_MLP_NORM] + D);
        __syncthreads();
        pg8::run_gemm(lds, (const bf16_t*)(ws + B_ACT), (const bf16_t*)(ws + W_DOWN), D, DFF, Ep, ksp, 1 << 20); }
    GRID_SYNC();
    if (PH(11)) { PHASE_VARS; pg8::EpiGateB Ep{(const bf16_t*)X, E, SS + 3 * M, kp->in[I_PLE_NORM], H, SS + 2 * M, nullptr};
        const int ksp = (G == 256) ? ((bid >> 3) % 3) : (1 << 20);
        pg8::run_gemm(lds, (const bf16_t*)X, (const bf16_t*)(ws + W_GATE), D, D, Ep, 0, ksp);
        convert_matrix(kp->in[I_WDOWN] + (size_t)D * DFF, DFF, D, (bf16_t*)(ws + W_DOWN), scr, gw, ngw, lane);
        __syncthreads();
        pg8::run_gemm(lds, (const bf16_t*)X, (const bf16_t*)(ws + W_GATE), D, D, Ep, ksp, 1 << 20); }
    GRID_SYNC();

    if (PH(7)) {
            { PHASE_VARS; pg8::EpiBf16<0> Ep{(bf16_t*)(ws + B_Z), OD_IN, SS + 2 * M, nullptr}; pg8::run_gemm(lds, H, (const bf16_t*)(ws + W_ODIN), OD_IN, D, Ep); }
            GRID_SYNC();
            {
                PHASE_VARS;
                const bf16_t* Z3 = (const bf16_t*)(ws + B_Z); bf16_t* SQ = (bf16_t*)(ws + B_SQ); bf16_t* SK = (bf16_t*)(ws + B_SK); bf16_t* SVT = (bf16_t*)(ws + B_SVT);
                const float CS = 0.08838834764831845f * LOG2E;
                const int hs = lane >> 3, j8 = 8 * (lane & 7);
                float gq[16], gk[16];
#pragma unroll
                for (int j = 0; j < 8; ++j) { gq[j] = kp->in[I_SWAQ_NORM][j8 + j]; gq[8 + j] = kp->in[I_SWAQ_NORM][64 + j8 + j]; gk[j] = kp->in[I_SWAK_NORM][j8 + j]; gk[8 + j] = kp->in[I_SWAK_NORM][64 + j8 + j]; }
                _Pragma("unroll 1") for (int rp_ = 0; rp_ < REP_PREP; ++rp_) for (int tok = gw; tok < M; tok += ngw) {
                    const int pos = tok_pos(tok);
                    const f32x4 c0 = *(const f32x4*)(ROPE128 + pos * 64 + j8), c1 = *(const f32x4*)(ROPE128 + pos * 64 + j8 + 4);
                    const f32x4 s0 = *(const f32x4*)(ROPE128 + 4096 * 64 + pos * 64 + j8), s1 = *(const f32x4*)(ROPE128 + 4096 * 64 + pos * 64 + j8 + 4);
                    const float cc[8] = {c0[0], c0[1], c0[2], c0[3], c1[0], c1[1], c1[2], c1[3]}, sn[8] = {s0[0], s0[1], s0[2], s0[3], s1[0], s1[1], s1[2], s1[3]};
                    const bf16_t* z = Z3 + (size_t)tok * OD_IN;
#pragma unroll
                    for (int p = 0; p < 3; ++p) {
                        const int head = 8 * p + hs; const bool act = head < 20; const int hc = act ? head : 19;
                        const bf16_t* src = z + hc * 128;
                        const u32x4 w1 = *(const u32x4*)(src + j8), w2 = *(const u32x4*)(src + 64 + j8);
                        const float a[8] = {bflo(w1.x), bfhi(w1.x), bflo(w1.y), bfhi(w1.y), bflo(w1.z), bfhi(w1.z), bflo(w1.w), bfhi(w1.w)};
                        const float b[8] = {bflo(w2.x), bfhi(w2.x), bflo(w2.y), bfhi(w2.y), bflo(w2.z), bfhi(w2.z), bflo(w2.w), bfhi(w2.w)};
                        float ss = 0.f;
#pragma unroll
                        for (int j = 0; j < 8; ++j) ss += a[j] * a[j] + b[j] * b[j];
                        const bool isq = hc < 16;
                        const float ri = (isq ? CS : 1.0f) / sqrtf(group_sum<8>(ss) * (1.f / 128.f) + EPS);
                        float o1[8], o2[8];
#pragma unroll
                        for (int j = 0; j < 8; ++j) { const float y1 = a[j] * ri * (isq ? gq[j] : gk[j]), y2 = b[j] * ri * (isq ? gq[8 + j] : gk[8 + j]); o1[j] = y1 * cc[j] - y2 * sn[j]; o2[j] = y2 * cc[j] + y1 * sn[j]; }
                        u32x4 v1, v2;
                        v1.x = cvt_pk_bf16(o1[0], o1[1]); v1.y = cvt_pk_bf16(o1[2], o1[3]); v1.z = cvt_pk_bf16(o1[4], o1[5]); v1.w = cvt_pk_bf16(o1[6], o1[7]);
                        v2.x = cvt_pk_bf16(o2[0], o2[1]); v2.y = cvt_pk_bf16(o2[2], o2[3]); v2.z = cvt_pk_bf16(o2[4], o2[5]); v2.w = cvt_pk_bf16(o2[6], o2[7]);
                        bf16_t* dst = isq ? SQ + (size_t)tok * 2048 + hc * 128 : SK + (size_t)tok * 512 + (hc - 16) * 128;
                        if (act) { *(u32x4*)(dst + j8) = v1; *(u32x4*)(dst + 64 + j8) = v2; }
                    }
                }
                __syncthreads();
                _Pragma("unroll 1") for (int rp_ = 0; rp_ < REP_PREP; ++rp_) for (int it = bid; it < 256 * 4; it += G) { const int tt = it >> 2, h = it & 3;
                    vt_item(lds, Z3 + (size_t)(tt * 64) * OD_IN + 2560 + h * 128, OD_IN, SVT + (size_t)(h * 128) * M, tt * 64); }
            }
            GRID_SYNC();
            {
                PHASE_VARS;
                const bf16_t* SQ = (const bf16_t*)(ws + B_SQ); const bf16_t* SK = (const bf16_t*)(ws + B_SK); const bf16_t* SVT = (const bf16_t*)(ws + B_SVT);
                bf16_t* OC = (bf16_t*)(ws + B_OCAT1);
                _Pragma("unroll 1") for (int rep_ = 0; rep_ < REP_SWA; ++rep_)
                for (int u = bid; u < 1024; u += G) {
                    int kvh = u & 3, ch = u >> 2;
                    if (G == 256) { const int b = u & 255, x = b & 7, j = b >> 3; kvh = u >> 8; ch = 32 * x + j; }
                    const int tok0 = ch * 64;
                    const int seqbase = tok0 < 8192 ? (tok0 & ~4095) : (tok0 & ~2047); const int T = tok0 < 8192 ? 4096 : 2048;
                    const int head = kvh * 4 + (wave >> 1);
                    const int tq = tok0 + (wave & 1) * 32 + (lane & 31);
                    int tlo = ch - 2, thi = ch + 3; const int s0 = seqbase >> 6, s1 = (seqbase + T) >> 6; tlo = tlo < s0 ? s0 : tlo; thi = thi > s1 ? s1 : thi;
                    const float sink = kp->in[I_SINKS][head] * LOG2E;
                    attn_unit<128, 2>(lds, SQ + (size_t)tq * 2048 + head * 128, SK + kvh * 128, 512, SVT + (size_t)(kvh * 128) * M, tlo, thi, tlo, thi, tq, 0, sink, lane < 32 ? 1.f : 0.f,
                                      OC + (size_t)tq * 2048 + head * 128);
                }
            }
            GRID_SYNC();
            { PHASE_VARS; pg8::EpiResidB Ep{H, nullptr, nullptr, (bf16_t*)X, SS + 1 * M, nullptr}; pg8::run_gemm(lds, (const bf16_t*)(ws + B_OCAT1), (const bf16_t*)(ws + W_ODOUT), D, D, Ep); }
            { PHASE_VARS; pg8::EpiBf16<0> Ep{E, D, nullptr, SS + 4 * M}; pg8::run_gemm(lds, (const bf16_t*)(ws + WS_PB1), (const bf16_t*)(ws + W_PROJ), D, 256, Ep); }
            GRID_SYNC();
    }
    if (PH(9)) { PHASE_VARS; pg8::EpiBf16<1> Ep{(bf16_t*)(ws + B_ACT), DFF, nullptr, nullptr}; pg8::run_gemm(lds, (const bf16_t*)X, (const bf16_t*)(ws + W_UP), DFF, D, Ep); }
    GRID_SYNC();
    if (PH(10)) { PHASE_VARS; pg8::EpiResidB Ep{(const bf16_t*)X, nullptr, nullptr, H, nullptr, SS + 1 * M}; pg8::run_gemm(lds, (const bf16_t*)(ws + B_ACT), (const bf16_t*)(ws + W_DOWN), D, DFF, Ep); }
    GRID_SYNC();
    if (PH(11)) { PHASE_VARS; pg8::EpiGateF32 Ep{H, E, SS + 4 * M, kp->in[I_PLE_NORM] + D, X}; pg8::run_gemm(lds, H, (const bf16_t*)(ws + W_GATE1), D, D, Ep); }
}

extern "C" void kernel_launch(void* const* d_in, const int* in_sizes, int n_in, void* d_out, int out_size, void* d_ws, size_t ws_size, hipStream_t stream) {
    static int grid_blocks = 0;
    if (!grid_blocks) {
        int dev = 0, cus = 0, per_cu = 0;
        hipGetDevice(&dev);
        hipDeviceGetAttribute(&cus, hipDeviceAttributeMultiprocessorCount, dev);
        hipFuncSetAttribute((const void*)fwd_megakernel, hipFuncAttributeMaxDynamicSharedMemorySize, LDS_BYTES);
        hipOccupancyMaxActiveBlocksPerMultiprocessor(&per_cu, (const void*)fwd_megakernel, NTHREADS, LDS_BYTES);
        if (per_cu < 1) per_cu = 1;
        grid_blocks = cus * per_cu;
        if (ws_size < WS_END) fprintf(stderr, "kernel_launch: workspace too small: %zu < %zu\n", ws_size, (size_t)WS_END);
    }
    Params p{};
    for (int i = 0; i < N_IN; ++i) p.in[i] = (const float*)d_in[i];
    p.out = (float*)d_out; p.ws = (unsigned char*)d_ws;
    (void)hipMemsetAsync((char*)d_ws + WS_BAR, 0, XCD_BAR_WORDS * sizeof(unsigned), stream);
    void* args[] = {&p};
    hipError_t e = hipLaunchCooperativeKernel((const void*)fwd_megakernel, dim3(grid_blocks), dim3(NTHREADS), args, LDS_BYTES, stream);
    if (e != hipSuccess) fprintf(stderr, "cooperative launch failed: %s (grid %d)\n", hipGetErrorString(e), grid_blocks);
}
```

```cpp
#include <hip/hip_runtime.h>
#include <hip/hip_cooperative_groups.h>
#include <cstdio>
namespace cg = cooperative_groups;

#define LAS __attribute__((address_space(3)))
typedef unsigned short bf16_t;
typedef short bf16x8 __attribute__((ext_vector_type(8)));
typedef float f32x4 __attribute__((ext_vector_type(4)));
typedef float f32x16 __attribute__((ext_vector_type(16)));
typedef unsigned u32x4 __attribute__((ext_vector_type(4)));
typedef unsigned u32x2 __attribute__((ext_vector_type(2)));

constexpr int M = 16384, D = 2048, DFF = 8192;
constexpr int EV_IN = 3904, EV_INP = 4096, OD_IN = 3072;
constexpr float EPS = 1e-6f;
constexpr float LOG2E = 1.4426950408889634f;
constexpr int NTHREADS = 512, NWAVES = 8;
constexpr int LDS_BYTES = 136 * 1024;
#ifndef ONLY
#define ONLY 0xffffffff
#endif
#define PH(b) (((ONLY) >> (b)) & 1u)
#ifndef REP_CONV
#define REP_CONV 1
#endif
#ifndef REP_ATT
#define REP_ATT 1
#endif
#define REP_MLA 1
#define REP_NA 1
#define REP_SWA 1
#ifndef REP_PREP
#define REP_PREP 1
#endif

enum { I_XP = 0, I_XS, I_PP, I_PS, I_ATTN_NORM, I_MLP_NORM, I_WUP, I_WDOWN, I_PLE_GATE, I_PLE_PROJ, I_PLE_NORM, I_EV_WIN, I_QA_NORM, I_WQB, I_KVA_NORM,
       I_WKVB, I_QNOPE_NORM, I_QROPE_NORM, I_KNOPE_NORM, I_KROPE_NORM, I_NAQ_NORM, I_NAK_NORM, I_RPB, I_EV_WOUT, I_OD_WIN, I_SWAQ_NORM, I_SWAK_NORM, I_SINKS, I_OD_WOUT, N_IN };

struct Params { const float* in[N_IN]; float* out; unsigned char* ws; };
typedef const Params __attribute__((address_space(4)))* KP;
#define KARG(name) KP name = (KP)__builtin_amdgcn_kernarg_segment_ptr(); asm volatile("" : "+s"(name))

constexpr size_t MiB = 1024 * 1024;
constexpr size_t W_UP = 0, W_DOWN = 32 * MiB, W_GATE = 64 * MiB, W_PROJ = 72 * MiB, W_MIX = 73 * MiB;
constexpr size_t W_EVIN = W_MIX, W_QB = W_MIX + 16 * MiB, W_KVB = W_QB + 3 * MiB / 2, W_EVOUT = W_KVB + 1 * MiB;
constexpr size_t W_ODIN = W_MIX, W_ODOUT = W_MIX + 12 * MiB;
constexpr size_t WS_H = 100 * MiB, WS_E = 164 * MiB, WS_PB = 228 * MiB, WS_BIG = 236 * MiB, WS_MISC = 492 * MiB;
constexpr size_t WS_BAR = WS_MISC + 512 * 1024;
constexpr size_t WS_SS = WS_MISC;
constexpr size_t WS_ROPE64 = WS_MISC + 1 * MiB, WS_ROPE128 = WS_MISC + 2 * MiB, W_GATE1 = WS_MISC + 4 * MiB, WS_PB1 = WS_MISC + 12 * MiB, WS_END = WS_MISC + 20 * MiB;
constexpr size_t B_H2 = WS_BIG + 192 * MiB;
constexpr size_t B_Z = WS_BIG;
constexpr size_t B_Q1 = WS_BIG, B_KV1 = WS_BIG + 48 * MiB;
constexpr size_t B_NQ = WS_BIG + 128 * MiB, B_NK = WS_BIG + 160 * MiB, B_NVT = WS_BIG + 192 * MiB;
constexpr size_t B_QN = WS_BIG + 224 * MiB, B_KVN = WS_BIG + 240 * MiB, B_KR = WS_BIG + 248 * MiB;
constexpr size_t B_OCAT0 = WS_BIG;
constexpr size_t HE_QM = WS_H, HE_KM = WS_H + 48 * MiB, HE_VTM = WS_H + 96 * MiB;
constexpr size_t B_SQ = WS_BIG + 96 * MiB, B_SK = WS_BIG + 160 * MiB, B_SVT = WS_BIG + 176 * MiB, B_OCAT1 = WS_BIG + 192 * MiB;
constexpr size_t B_ACT = WS_BIG;

__device__ __forceinline__ unsigned cvt_pk_bf16(float lo, float hi) { unsigned r; asm volatile("v_cvt_pk_bf16_f32 %0, %1, %2" : "=v"(r) : "v"(lo), "v"(hi)); return r; }
__device__ __forceinline__ float bf2f(unsigned short b) { return __uint_as_float(((unsigned)b) << 16); }
__device__ __forceinline__ float bflo(unsigned w) { return __uint_as_float(w << 16); }
__device__ __forceinline__ float bfhi(unsigned w) { return __uint_as_float(w & 0xffff0000u); }
__device__ __forceinline__ unsigned short f2bf(float f) { return (unsigned short)(cvt_pk_bf16(f, 0.f) & 0xffffu); }
__device__ __forceinline__ float wave_sum(float v) {
#pragma unroll
    for (int o = 1; o < 64; o <<= 1) v += __shfl_xor(v, o);
    return v;
}
template <int W> __device__ __forceinline__ float group_sum(float v) {
#pragma unroll
    for (int o = 1; o < W; o <<= 1) v += __shfl_xor(v, o);
    return v;
}
__device__ __forceinline__ int tok_pos(int tok) { return tok < 8192 ? (tok & 4095) : (tok & 2047); }


#define XB_TMO      128
#define XB_XCNT(j)  (256  + 64 * (j))
#define XB_XSUB(j)  (1280 + 64 * (j))
#define XB_XGEN(j)  (2304 + 64 * (j))
#define XB_TOP      3328
#define XB_TOPGEN   3392
#define XCD_BAR_WORDS 3456
#define XB_SPIN_CAP (1u << 18)
__device__ __forceinline__ unsigned xb_ld(unsigned* p)              { return __hip_atomic_load(p, __ATOMIC_RELAXED, __HIP_MEMORY_SCOPE_AGENT); }
__device__ __forceinline__ unsigned xb_add(unsigned* p, unsigned v) { return __hip_atomic_fetch_add(p, v, __ATOMIC_RELAXED, __HIP_MEMORY_SCOPE_AGENT); }
__device__ __forceinline__ unsigned xb_xcc_id() { return (unsigned)__builtin_amdgcn_s_getreg((3 << 11) | 20) & 0xFu; }
#define XB_SPIN(cond, bar) do { unsigned _sp = 0; while (cond) { __builtin_amdgcn_s_sleep(1); \
    if ((++_sp & 255u) == 0u) { if (xb_ld(&(bar)[XB_TMO])) break; if (_sp > XB_SPIN_CAP) { atomicAdd(&(bar)[XB_TMO], 1u); break; } } } } while (0)
struct XcdBarrier { unsigned* bar; unsigned x; volatile LAS unsigned* st; };
__device__ __forceinline__ XcdBarrier xcd_barrier_post(unsigned* bar, volatile LAS unsigned* st) {
    XcdBarrier b; b.bar = bar; b.x = xb_xcc_id(); b.st = st;
    if (threadIdx.x == 0) (void)xb_add(&bar[XB_XCNT(b.x)], 1u);
    return b;
}
__device__ __forceinline__ void xcd_barrier_complete(unsigned* bar, unsigned x, unsigned& nloc, unsigned& nx) {
    const unsigned G = gridDim.x * gridDim.y * gridDim.z;
    unsigned sum, cnt, mine, sp = 0u;
    for (;;) {
        sum = 0u; cnt = 0u; mine = 0u;
#pragma unroll
        for (unsigned j = 0; j < 16; ++j) { const unsigned c = xb_ld(&bar[XB_XCNT(j)]); sum += c; cnt += (c > 0u) ? 1u : 0u; mine = (j == x) ? c : mine; }
        if (sum == G) break;
        __builtin_amdgcn_s_sleep(1);
        if ((++sp & 255u) == 0u) { if (xb_ld(&bar[XB_TMO])) break; if (sp > XB_SPIN_CAP) { atomicAdd(&bar[XB_TMO], 1u); break; } }
    }
    nloc = mine > 0u ? mine : 1u; nx = cnt > 0u ? cnt : 1u;
}
__device__ __forceinline__ void xcd_barrier(const XcdBarrier& b) {
    asm volatile("s_waitcnt vmcnt(0)" ::: "memory");
    __syncthreads();
    if (threadIdx.x == 0) {
        unsigned* bar = b.bar;
        __builtin_amdgcn_s_waitcnt(0);
        unsigned nloc = b.st[0], nx = b.st[1];
        if (nloc == 0u) { xcd_barrier_complete(bar, b.x, nloc, nx); b.st[0] = nloc; b.st[1] = nx; }
        const unsigned old = xb_add(&bar[XB_XSUB(b.x)], 1u);
        const unsigned gen = old / nloc;
        if (old + 1u == (gen + 1u) * nloc) {
            __builtin_amdgcn_fence(__ATOMIC_RELEASE, "agent");
            asm volatile("s_waitcnt vmcnt(0)" ::: "memory");
            const unsigned og = xb_add(&bar[XB_TOP], 1u);
            const unsigned tg = og / nx;
            if (og + 1u == (tg + 1u) * nx) xb_add(&bar[XB_TOPGEN], 1u);
            else XB_SPIN(xb_ld(&bar[XB_TOPGEN]) == tg, bar);
            __builtin_amdgcn_fence(__ATOMIC_ACQUIRE, "agent");
            xb_add(&bar[XB_XGEN(b.x)], 1u);
            asm volatile("s_waitcnt vmcnt(0)" ::: "memory");
        } else {
            XB_SPIN(xb_ld(&bar[XB_XGEN(b.x)]) == gen, bar);
            __builtin_amdgcn_fence(__ATOMIC_ACQUIRE, "agent");
            asm volatile("s_waitcnt vmcnt(0)" ::: "memory");
        }
    }
    __syncthreads();
}

namespace pg8 {
constexpr int BM = 256, BK = 64, HALF = 128, HTB = HALF * BK * 2, STAGE_BYTES = 8 * HTB, NXCD = 8, WGM = 8;
__device__ __forceinline__ int lds_byte(int r, int c) { const int st = (r >> 4) * 2 + (c >> 5), rr = r & 15, cc = c & 31, ob = rr * 64 + cc * 2; return st * 1024 + (ob ^ (((ob >> 9) & 1) << 5)); }
__device__ __forceinline__ void stage_rc(int b, int& R, int& C) { const int st = b / 1024, sb = b % 1024, swz = sb ^ (((sb >> 9) & 1) << 5); R = (st >> 1) * 16 + swz / 64; C = (st & 1) * 32 + (swz % 64) / 2; }
__device__ __forceinline__ int perm32(int rho) { const int n = rho >> 4, i = rho & 15; return 8 * (i >> 2) + 4 * n + (i & 3); }

struct Unit { int pm, pn; };
struct Gemm { const bf16_t* A; const bf16_t* Bt; int M, N, K; };
struct StaticOrder {
    int nM, nN, nwg, G, c, ioff, icnt;
    __device__ void init(int M_, int N_, int G_, int c_, int ioff_ = 0, int icnt_ = 1 << 20) { nM = M_ / BM; nN = N_ / BM; nwg = nM * nN; G = G_; c = c_; ioff = ioff_; icnt = icnt_; }
    __device__ bool next(int i, Unit& u) const {
        if (i >= icnt) return false;
        const long L = (long)(i + ioff) * G + c; if (L >= nwg) return false;
        int wgid = (int)L; { const int q = nwg / NXCD, r = nwg % NXCD, xcd = wgid % NXCD, off = wgid / NXCD; wgid = (xcd < r ? xcd * (q + 1) : r * (q + 1) + (xcd - r) * q) + off; }
        const int nig = WGM * nN, gid = wgid / nig, fm = gid * WGM, gsz = (nM - fm) < WGM ? (nM - fm) : WGM;
        u.pm = fm + ((wgid % nig) % gsz); u.pn = (wgid % nig) / gsz; return true;
    }
};

__device__ __forceinline__ unsigned dpp_ror8(unsigned x) { return (unsigned)__builtin_amdgcn_update_dpp(0, (int)x, 0x128, 0xf, 0xf, false); }
__device__ __forceinline__ void store_pair_lines(bf16_t* O, int ldc, int row, int fr, int col0, u32x4 wA, u32x4 wB) {
    const u32x4 sA = {dpp_ror8(wA.x), dpp_ror8(wA.y), dpp_ror8(wA.z), dpp_ror8(wA.w)}, sB = {dpp_ror8(wB.x), dpp_ror8(wB.y), dpp_ror8(wB.z), dpp_ror8(wB.w)};
    const bool lo = fr < 8;
    const u32x4 o1 = lo ? wA : sB, o2 = lo ? sA : wB;
    const int r1 = row - fr + (fr & 7), cb = col0 + (lo ? 0 : 8);
    *(u32x4*)(O + (size_t)r1 * ldc + cb) = o1;
    *(u32x4*)(O + (size_t)(r1 + 8) * ldc + cb) = o2;
}
__device__ __forceinline__ void load_pair_lines(const bf16_t* P, int ld, int row, int fr, int col0, u32x4& wA, u32x4& wB, int boff = 8) {
    const bool lo = fr < 8;
    const int r1 = row - fr + (fr & 7), cb = col0 + (lo ? 0 : boff);
    const u32x4 l1 = *(const u32x4*)(P + (size_t)r1 * ld + cb), l2 = *(const u32x4*)(P + (size_t)(r1 + 8) * ld + cb);
    const u32x4 s1 = {dpp_ror8(l1.x), dpp_ror8(l1.y), dpp_ror8(l1.z), dpp_ror8(l1.w)}, s2 = {dpp_ror8(l2.x), dpp_ror8(l2.y), dpp_ror8(l2.z), dpp_ror8(l2.w)};
    wA = lo ? l1 : s2; wB = lo ? s1 : l2;
}
template <int ACT  > struct EpiBf16 {
    static constexpr bool PERM = true, F32OUT = false;
    bf16_t* O; int ldc;
    const float* ssin;
    float* ssout;
    __device__ __forceinline__ void operator()(const f32x4 (&acc)[2][2][4][2], const Unit& u, int wr, int wc, int fr, int fq) const {
        const int row0 = u.pm * BM + wr * 64 + fr; const int col0 = u.pn * BM + wc * 64 + 16 * fq;
#pragma unroll
        for (int ai = 0; ai < 2; ++ai)
#pragma unroll
            for (int m = 0; m < 4; ++m) { const int row = row0 + ai * HALF + m * 16;
                const float rs = ssin ? __builtin_amdgcn_rsqf(ssin[row] * (1.f / D) + EPS) : 1.0f; float sq = 0.f; u32x4 w[2];
#pragma unroll
                for (int bj = 0; bj < 2; ++bj) { f32x4 v0 = acc[ai][bj][m][0] * rs, v1 = acc[ai][bj][m][1] * rs;
                    if (ACT == 1) {
#pragma unroll
                        for (int j = 0; j < 4; ++j) { const float a = fmaxf(v0[j], 0.f), b = fmaxf(v1[j], 0.f); v0[j] = a * a; v1[j] = b * b; } }
                    sq += (v0[0] * v0[0] + v0[1] * v0[1]) + (v0[2] * v0[2] + v0[3] * v0[3]) + (v1[0] * v1[0] + v1[1] * v1[1]) + (v1[2] * v1[2] + v1[3] * v1[3]);
                    w[bj].x = cvt_pk_bf16(v0[0], v0[1]); w[bj].y = cvt_pk_bf16(v0[2], v0[3]); w[bj].z = cvt_pk_bf16(v1[0], v1[1]); w[bj].w = cvt_pk_bf16(v1[2], v1[3]); }
                store_pair_lines(O, ldc, row, fr, col0, w[0], w[1]);
                if (ssout) { sq += __shfl_xor(sq, 16); sq += __shfl_xor(sq, 32); if (fq == 0) unsafeAtomicAdd(ssout + row, sq); } }
    }
};
struct EpiResid {
    static constexpr bool PERM = false, F32OUT = false;
    float* X; bf16_t* XB; float* ssout;
    const float* rsin;
    const float* src_p; const float* src_s;
    __device__ __forceinline__ void operator()(const f32x4 (&acc)[2][2][4][2], const Unit& u, int wr, int wc, int fr, int fq) const {
        const int row0 = u.pm * BM + wr * 64 + fr, col0 = u.pn * BM + wc * 32 + 4 * fq;
#pragma unroll
        for (int ai = 0; ai < 2; ++ai)
#pragma unroll
            for (int m = 0; m < 4; ++m) { const int row = row0 + ai * HALF + m * 16; const size_t off = (size_t)row * D + col0; float sq = 0.f;
                const float sc = rsin ? __builtin_amdgcn_rcpf(rsin[row] * (1.f / D) + EPS) : 1.0f;
                const float* rp = src_p ? (row < 8192 ? src_p + off : src_s + (off - (size_t)8192 * D)) : X + off;
#pragma unroll
                for (int bj = 0; bj < 2; ++bj)
#pragma unroll
                    for (int n = 0; n < 2; ++n) { const f32x4 o = *(const f32x4*)(rp + bj * HALF + n * 16) + acc[ai][bj][m][n] * sc; *(f32x4*)(X + off + bj * HALF + n * 16) = o;
                        sq += (o[0] * o[0] + o[1] * o[1]) + (o[2] * o[2] + o[3] * o[3]);
                        u32x2 w; w.x = cvt_pk_bf16(o[0], o[1]); w.y = cvt_pk_bf16(o[2], o[3]); *(u32x2*)(XB + off + bj * HALF + n * 16) = w; }
                if (ssout) { sq += __shfl_xor(sq, 16); sq += __shfl_xor(sq, 32); if (fq == 0) unsafeAtomicAdd(ssout + row, sq); } }
    }
};
struct EpiGate {
    static constexpr bool PERM = false, F32OUT = false;
    float* X; const bf16_t* E; const float* sse; const float* g; bf16_t* XB; float* ssout;
    __device__ __forceinline__ void operator()(const f32x4 (&acc)[2][2][4][2], const Unit& u, int wr, int wc, int fr, int fq) const {
        const int row0 = u.pm * BM + wr * 64 + fr, col0 = u.pn * BM + wc * 32 + 4 * fq;
        f32x4 gv[2][2];
#pragma unroll
        for (int bj = 0; bj < 2; ++bj)
#pragma unroll
            for (int n = 0; n < 2; ++n) gv[bj][n] = *(const f32x4*)(g + col0 + bj * HALF + n * 16);
#pragma unroll
        for (int ai = 0; ai < 2; ++ai)
#pragma unroll
            for (int m = 0; m < 4; ++m) { const int row = row0 + ai * HALF + m * 16; const size_t off = (size_t)row * D + col0; const float ri = __builtin_amdgcn_rsqf(sse[row] * (1.f / D) + EPS); float sq = 0.f;
#pragma unroll
                for (int bj = 0; bj < 2; ++bj)
#pragma unroll
                    for (int n = 0; n < 2; ++n) { float* p = X + off + bj * HALF + n * 16; const u32x2 ew = *(const u32x2*)(E + off + bj * HALF + n * 16);
                        const f32x4 a = acc[ai][bj][m][n]; const f32x4 gg = gv[bj][n]; f32x4 o = *(const f32x4*)p;
                        const float e0 = bflo(ew.x), e1 = bfhi(ew.x), e2 = bflo(ew.y), e3 = bfhi(ew.y);
                        o[0] += e0 * ri * gg[0] * __builtin_amdgcn_rcpf(1.f + __builtin_amdgcn_exp2f(-a[0] * LOG2E));
                        o[1] += e1 * ri * gg[1] * __builtin_amdgcn_rcpf(1.f + __builtin_amdgcn_exp2f(-a[1] * LOG2E));
                        o[2] += e2 * ri * gg[2] * __builtin_amdgcn_rcpf(1.f + __builtin_amdgcn_exp2f(-a[2] * LOG2E));
                        o[3] += e3 * ri * gg[3] * __builtin_amdgcn_rcpf(1.f + __builtin_amdgcn_exp2f(-a[3] * LOG2E));
                        *(f32x4*)p = o;
                        if (XB) { sq += (o[0] * o[0] + o[1] * o[1]) + (o[2] * o[2] + o[3] * o[3]);
                            u32x2 w; w.x = cvt_pk_bf16(o[0], o[1]); w.y = cvt_pk_bf16(o[2], o[3]); *(u32x2*)(XB + off + bj * HALF + n * 16) = w; } }
                if (XB) { sq += __shfl_xor(sq, 16); sq += __shfl_xor(sq, 32); if (fq == 0) unsafeAtomicAdd(ssout + row, sq); } }
    }
};

struct EpiResidB {
    static constexpr bool PERM = true, F32OUT = false;
    const bf16_t* R;
    const float* src_p; const float* src_s;
    bf16_t* O;
    float* ssout;
    const float* rsin;
    __device__ __forceinline__ void operator()(const f32x4 (&acc)[2][2][4][2], const Unit& u, int wr, int wc, int fr, int fq) const {
        const int row0 = u.pm * BM + wr * 64 + fr, col0 = u.pn * BM + wc * 64 + 16 * fq;
#pragma unroll
        for (int ai = 0; ai < 2; ++ai)
#pragma unroll
            for (int m = 0; m < 4; ++m) { const int row = row0 + ai * HALF + m * 16; const size_t off = (size_t)row * D + col0; float sq = 0.f; u32x4 w[2];
                const float sc = rsin ? __builtin_amdgcn_rcpf(rsin[row] * (1.f / D) + EPS) : 1.0f;
                u32x4 rr[2]; if (R) load_pair_lines(R, D, row, fr, col0, rr[0], rr[1]);
#pragma unroll
                for (int bj = 0; bj < 2; ++bj) { f32x4 r0, r1;
                    if (R) { const u32x4 rw = rr[bj]; r0 = (f32x4){bflo(rw.x), bfhi(rw.x), bflo(rw.y), bfhi(rw.y)}; r1 = (f32x4){bflo(rw.z), bfhi(rw.z), bflo(rw.w), bfhi(rw.w)}; }
                    else { const float* rp = (row < 8192 ? src_p + off : src_s + (off - (size_t)8192 * D)) + 8 * bj; r0 = *(const f32x4*)rp; r1 = *(const f32x4*)(rp + 4); }
                    const f32x4 o0 = r0 + acc[ai][bj][m][0] * sc, o1 = r1 + acc[ai][bj][m][1] * sc;
                    sq += (o0[0] * o0[0] + o0[1] * o0[1]) + (o0[2] * o0[2] + o0[3] * o0[3]) + (o1[0] * o1[0] + o1[1] * o1[1]) + (o1[2] * o1[2] + o1[3] * o1[3]);
                    w[bj].x = cvt_pk_bf16(o0[0], o0[1]); w[bj].y = cvt_pk_bf16(o0[2], o0[3]); w[bj].z = cvt_pk_bf16(o1[0], o1[1]); w[bj].w = cvt_pk_bf16(o1[2], o1[3]); }
                store_pair_lines(O, D, row, fr, col0, w[0], w[1]);
                if (ssout) { sq += __shfl_xor(sq, 16); sq += __shfl_xor(sq, 32); if (fq == 0) unsafeAtomicAdd(ssout + row, sq); } }
    }
};
struct EpiGateB {
    static constexpr bool PERM = true, F32OUT = false;
    const bf16_t* R; const bf16_t* E; const float* sse; const float* g; bf16_t* O; float* ssout; float* OUT;
    __device__ __forceinline__ void operator()(const f32x4 (&acc)[2][2][4][2], const Unit& u, int wr, int wc, int fr, int fq) const {
        const int row0 = u.pm * BM + wr * 64 + fr, col0 = u.pn * BM + wc * 64 + 16 * fq;
        f32x4 gv[2][2];
#pragma unroll
        for (int bj = 0; bj < 2; ++bj) { gv[bj][0] = *(const f32x4*)(g + col0 + 8 * bj); gv[bj][1] = *(const f32x4*)(g + col0 + 8 * bj + 4); }
#pragma unroll
        for (int ai = 0; ai < 2; ++ai)
#pragma unroll
            for (int m = 0; m < 4; ++m) { const int row = row0 + ai * HALF + m * 16; const size_t off = (size_t)row * D + col0; const float ri = __builtin_amdgcn_rsqf(sse[row] * (1.f / D) + EPS); float sq = 0.f; u32x4 w[2];
                u32x4 rr[2], ee[2]; load_pair_lines(R, D, row, fr, col0, rr[0], rr[1]); load_pair_lines(E, D, row, fr, col0, ee[0], ee[1]);
#pragma unroll
                for (int bj = 0; bj < 2; ++bj) { const u32x4 rw = rr[bj], ew = ee[bj];
                    const float r[8] = {bflo(rw.x), bfhi(rw.x), bflo(rw.y), bfhi(rw.y), bflo(rw.z), bfhi(rw.z), bflo(rw.w), bfhi(rw.w)};
                    const float e[8] = {bflo(ew.x), bfhi(ew.x), bflo(ew.y), bfhi(ew.y), bflo(ew.z), bfhi(ew.z), bflo(ew.w), bfhi(ew.w)};
                    float o[8];
#pragma unroll
                    for (int j = 0; j < 8; ++j) { const float a = acc[ai][bj][m][j >> 2][j & 3]; const float gg = gv[bj][j >> 2][j & 3];
                        o[j] = r[j] + e[j] * ri * gg * __builtin_amdgcn_rcpf(1.f + __builtin_amdgcn_exp2f(-a * LOG2E)); }
                    if (OUT) { *(f32x4*)(OUT + off + 8 * bj) = (f32x4){o[0], o[1], o[2], o[3]}; *(f32x4*)(OUT + off + 8 * bj + 4) = (f32x4){o[4], o[5], o[6], o[7]}; }
                    else { sq += (o[0] * o[0] + o[1] * o[1]) + (o[2] * o[2] + o[3] * o[3]) + (o[4] * o[4] + o[5] * o[5]) + (o[6] * o[6] + o[7] * o[7]);
                        w[bj].x = cvt_pk_bf16(o[0], o[1]); w[bj].y = cvt_pk_bf16(o[2], o[3]); w[bj].z = cvt_pk_bf16(o[4], o[5]); w[bj].w = cvt_pk_bf16(o[6], o[7]); } }
                if (!OUT) { store_pair_lines(O, D, row, fr, col0, w[0], w[1]);
                    sq += __shfl_xor(sq, 16); sq += __shfl_xor(sq, 32); if (fq == 0) unsafeAtomicAdd(ssout + row, sq); } }
    }
};

struct EpiGateF32 {
    static constexpr bool PERM = true, F32OUT = true;
    const bf16_t* R; const bf16_t* E; const float* sse; const float* g; float* OUT;
    __device__ __forceinline__ void operator()(const f32x4 (&acc)[2][2][4][2], const Unit& u, int wr, int wc, int fr, int fq) const {
        const int row0 = u.pm * BM + wr * 64 + fr, col0 = u.pn * BM + wc * 64 + 8 * fq;
        f32x4 gv[2][2];
#pragma unroll
        for (int bj = 0; bj < 2; ++bj) { gv[bj][0] = *(const f32x4*)(g + col0 + 32 * bj); gv[bj][1] = *(const f32x4*)(g + col0 + 32 * bj + 4); }
        const bool lo = fr < 8;
#pragma unroll
        for (int ai = 0; ai < 2; ++ai)
#pragma unroll
            for (int m = 0; m < 4; ++m) { const int row = row0 + ai * HALF + m * 16; const float ri = __builtin_amdgcn_rsqf(sse[row] * (1.f / D) + EPS);
                u32x4 rr[2], ee[2]; load_pair_lines(R, D, row, fr, col0, rr[0], rr[1], 32); load_pair_lines(E, D, row, fr, col0, ee[0], ee[1], 32);
                float* orow = OUT + (size_t)(row - fr + (fr & 7)) * D + col0 + (lo ? 0 : 4);
#pragma unroll
                for (int bj = 0; bj < 2; ++bj) { const u32x4 rw = rr[bj], ew = ee[bj];
                    const float r[8] = {bflo(rw.x), bfhi(rw.x), bflo(rw.y), bfhi(rw.y), bflo(rw.z), bfhi(rw.z), bflo(rw.w), bfhi(rw.w)};
                    const float e[8] = {bflo(ew.x), bfhi(ew.x), bflo(ew.y), bfhi(ew.y), bflo(ew.z), bfhi(ew.z), bflo(ew.w), bfhi(ew.w)};
                    float o[8];
#pragma unroll
                    for (int j = 0; j < 8; ++j) { const float a = acc[ai][bj][m][j >> 2][j & 3]; const float gg = gv[bj][j >> 2][j & 3];
                        o[j] = r[j] + e[j] * ri * gg * __builtin_amdgcn_rcpf(1.f + __builtin_amdgcn_exp2f(-a * LOG2E)); }
                    f32x4 o1, o2;
#pragma unroll
                    for (int j = 0; j < 4; ++j) { const unsigned a = __float_as_uint(o[j]), b = __float_as_uint(o[4 + j]); const unsigned sa = dpp_ror8(a), sb = dpp_ror8(b);
                        o1[j] = __uint_as_float(lo ? a : sb); o2[j] = __uint_as_float(lo ? sa : b); }
                    *(f32x4*)(orow + 32 * bj) = o1; *(f32x4*)(orow + (size_t)8 * D + 32 * bj) = o2; } }
    }
};

template <class Epi>
__device__ __forceinline__ void gemm_phase(LAS unsigned char* lds, const Gemm g, const StaticOrder& S, const Epi& E) {
    int tid = threadIdx.x; asm volatile("" : "+v"(tid));
    const int wid = __builtin_amdgcn_readfirstlane(tid >> 6), lane = tid & 63, wr = wid >> 2, wc = wid & 3, fr = lane & 15, fq = lane >> 4;
    const int K = g.K, nt = K / BK;
    unsigned voffA[2], voffB0[2], voffB1[2];
#pragma unroll
    for (int i = 0; i < 2; ++i) { int R, C; stage_rc(tid * 16 + i * 8192, R, C);
        const int Rw = 64 * (R >> 5) + 16 * ((R >> 2) & 3) + 4 * ((R >> 4) & 1) + (R & 3);
        const int Rf = 64 * (R >> 5) + 8 * ((R >> 2) & 3) + 4 * ((R >> 4) & 1) + (R & 3);
        const int Rb0 = Epi::PERM ? (Epi::F32OUT ? Rf : Rw) : R, Rb1 = Epi::PERM ? (Epi::F32OUT ? Rf + 32 : Rw + 8) : R + HALF;
        voffA[i] = (unsigned)(R * K + C) * 2u; voffB0[i] = (unsigned)(Rb0 * K + C) * 2u; voffB1[i] = (unsigned)(Rb1 * K + C) * 2u; }
    const size_t kstep = (size_t)(BK * 2);
    const size_t hstep = (size_t)HALF * K * 2;
    const size_t tstep = 2 * hstep;
    const unsigned ldsw = (unsigned)wid * 1024u;
    const int aoff = lds_byte(wr * 64 + fr, fq * 8), boff = lds_byte(wc * 32 + fr, fq * 8);
#define PG8_SA(b, h) (((b) * 2 + (h)) * HTB)
#define PG8_SB(b, h) ((4 + (b) * 2 + (h)) * HTB)
#define PG8_STAGE(bufoff, gbase, voff) do { _Pragma("unroll") for (int _i = 0; _i < 2; ++_i) \
        __builtin_amdgcn_global_load_lds((const unsigned*)((const char*)(gbase) + (voff)[_i]), (LAS unsigned*)(lds + (bufoff) + ldsw + _i * 8192), 16, 0, 0); } while (0)
#define PG8_LDA(dst, b, h) do { _Pragma("unroll") for (int m = 0; m < 4; ++m) _Pragma("unroll") for (int k = 0; k < 2; ++k) dst[m][k] = *(const LAS bf16x8*)(lds + PG8_SA(b, h) + aoff + m * 2048 + k * 1024); } while (0)
#define PG8_LDB(dst, b, h) do { _Pragma("unroll") for (int n = 0; n < 2; ++n) _Pragma("unroll") for (int k = 0; k < 2; ++k) dst[n][k] = *(const LAS bf16x8*)(lds + PG8_SB(b, h) + boff + n * 2048 + k * 1024); } while (0)
#define PG8_MMA(ai, bj, At, Bt) do { __builtin_amdgcn_s_setprio(1); _Pragma("unroll") for (int m = 0; m < 4; ++m) _Pragma("unroll") for (int n = 0; n < 2; ++n) _Pragma("unroll") for (int k = 0; k < 2; ++k) \
        acc[ai][bj][m][n] = __builtin_amdgcn_mfma_f32_16x16x32_bf16(Bt[n][k], At[m][k], acc[ai][bj][m][n], 0, 0, 0); __builtin_amdgcn_s_setprio(0); } while (0)
#define PG8_WAIT_V(n) asm volatile("s_waitcnt vmcnt(" #n ")" ::: "memory")
#define PG8_WAIT_L(n) asm volatile("s_waitcnt lgkmcnt(" #n ")" ::: "memory")
#define PG8_BAR __builtin_amdgcn_s_barrier()
#define PG8_SCHED __builtin_amdgcn_sched_barrier(0)
    Unit cur, nxt; int ui = 0;
    if (!S.next(0, cur)) return;
    f32x4 acc[2][2][4][2];
#pragma unroll
    for (int a = 0; a < 2; ++a)
#pragma unroll
        for (int b = 0; b < 2; ++b)
#pragma unroll
            for (int m = 0; m < 4; ++m)
#pragma unroll
                for (int n = 0; n < 2; ++n) acc[a][b][m][n] = (f32x4){0.f, 0.f, 0.f, 0.f};
    bf16x8 At[4][2], B0[2][2], B1[2][2];
    const char* cA = (const char*)g.A + (size_t)cur.pm * tstep; const char* cB = (const char*)g.Bt + (size_t)cur.pn * tstep;
    PG8_STAGE(PG8_SB(0, 0), cB, voffB0); PG8_STAGE(PG8_SA(0, 0), cA, voffA); PG8_STAGE(PG8_SB(0, 1), cB, voffB1); PG8_STAGE(PG8_SA(0, 1), cA + hstep, voffA);
    if (wr == 1) PG8_BAR;
    PG8_WAIT_V(4); PG8_BAR;
    PG8_STAGE(PG8_SB(1, 0), cB + kstep, voffB0); PG8_STAGE(PG8_SA(1, 0), cA + kstep, voffA); PG8_STAGE(PG8_SB(1, 1), cB + kstep, voffB1);
    PG8_WAIT_V(6); PG8_BAR;
    for (;;) {
        const bool has_next = S.next(ui + 1, nxt);
        const char* nA = has_next ? (const char*)g.A + (size_t)nxt.pm * tstep : cA; const char* nB = has_next ? (const char*)g.Bt + (size_t)nxt.pn * tstep : cB;
        for (int t = 0; t < nt; t += 2) {
            const bool last = (t == nt - 2);
            const char* a1 = cA + (size_t)(t + 1) * kstep;
            const char* a2 = last ? nA : cA + (size_t)(t + 2) * kstep; const char* b2 = last ? nB : cB + (size_t)(t + 2) * kstep;
            const char* a3 = a2 + kstep; const char* b3 = b2 + kstep;
            PG8_LDB(B0, 0, 0); PG8_SCHED; PG8_LDA(At, 0, 0); PG8_STAGE(PG8_SA(1, 1), a1 + hstep, voffA);
            PG8_WAIT_L(8); PG8_BAR; PG8_WAIT_L(0); PG8_MMA(0, 0, At, B0); PG8_BAR; PG8_SCHED;
            PG8_LDB(B1, 0, 1); PG8_STAGE(PG8_SB(0, 0), b2, voffB0);
            PG8_BAR; PG8_WAIT_L(0); PG8_MMA(0, 1, At, B1); PG8_BAR;
            PG8_LDA(At, 0, 1); PG8_STAGE(PG8_SA(0, 0), a2, voffA);
            PG8_BAR; PG8_WAIT_L(0); PG8_MMA(1, 0, At, B0); PG8_BAR; PG8_SCHED;
            PG8_STAGE(PG8_SB(0, 1), b2, voffB1);
            PG8_WAIT_V(6); PG8_BAR; PG8_MMA(1, 1, At, B1); PG8_BAR;
            PG8_LDB(B0, 1, 0); PG8_SCHED; PG8_LDA(At, 1, 0); PG8_STAGE(PG8_SA(0, 1), a2 + hstep, voffA);
            PG8_WAIT_L(8); PG8_BAR; PG8_WAIT_L(0); PG8_MMA(0, 0, At, B0); PG8_BAR; PG8_SCHED;
            PG8_LDB(B1, 1, 1); PG8_STAGE(PG8_SB(1, 0), b3, voffB0);
            PG8_BAR; PG8_WAIT_L(0); PG8_MMA(0, 1, At, B1); PG8_BAR;
            PG8_LDA(At, 1, 1); PG8_STAGE(PG8_SA(1, 0), a3, voffA);
            PG8_BAR; PG8_WAIT_L(0); PG8_MMA(1, 0, At, B0); PG8_BAR; PG8_SCHED;
            PG8_STAGE(PG8_SB(1, 1), b3, voffB1);
            PG8_WAIT_V(6); PG8_BAR; PG8_MMA(1, 1, At, B1); PG8_BAR;
        }
        E(acc, cur, wr, wc, fr, fq);
        if (!has_next) break;
#pragma unroll
        for (int a = 0; a < 2; ++a)
#pragma unroll
            for (int b = 0; b < 2; ++b)
#pragma unroll
                for (int m = 0; m < 4; ++m)
#pragma unroll
                    for (int n = 0; n < 2; ++n) acc[a][b][m][n] = (f32x4){0.f, 0.f, 0.f, 0.f};
        cur = nxt; cA = nA; cB = nB; ++ui;
    }
    PG8_WAIT_V(0);
    if (wr == 0) PG8_BAR;
    PG8_BAR;
#undef PG8_SA
#undef PG8_SB
#undef PG8_STAGE
#undef PG8_LDA
#undef PG8_LDB
#undef PG8_MMA
#undef PG8_WAIT_V
#undef PG8_WAIT_L
#undef PG8_BAR
#undef PG8_SCHED
}
template <class Epi>
__device__ __forceinline__ void run_gemm(LAS unsigned char* lds, const bf16_t* A, const bf16_t* Bt, int N, int K, const Epi& E, int ioff = 0, int icnt = 1 << 20) {
    Gemm g{A, Bt, M, N, K}; StaticOrder S; S.init(M, N, (int)gridDim.x, (int)blockIdx.x, ioff, icnt);
    gemm_phase<Epi>(lds, g, S, E);
    __syncthreads();
}
}

__device__ __forceinline__ void transpose_item(const float* W, int K, int N, bf16_t* WT, LAS float* scr, int item, int lane, const float* gk) {
    const int nblk = N / 64, kb = item / nblk, nb = item % nblk, k0 = 64 * kb, n0 = 64 * nb;
    f32x4 v[16];
#pragma unroll
    for (int i = 0; i < 16; ++i) { const int kk = 4 * i + (lane >> 4); v[i] = *(const f32x4*)(W + (size_t)(k0 + kk) * N + n0 + 4 * (lane & 15)); }
    if (gk) {
#pragma unroll
        for (int i = 0; i < 16; ++i) v[i] *= gk[k0 + 4 * i + (lane >> 4)]; }
#pragma unroll
    for (int i = 0; i < 16; ++i) { LAS float* d = scr + (4 * i + (lane >> 4)) * 65 + 4 * (lane & 15); d[0] = v[i][0]; d[1] = v[i][1]; d[2] = v[i][2]; d[3] = v[i][3]; }
    asm volatile("s_waitcnt lgkmcnt(0)" ::: "memory");
    const int c = lane & 7;
#pragma unroll
    for (int j = 0; j < 8; ++j) { const int n = (lane >> 3) + 8 * j; const LAS float* s = scr + (8 * c) * 65 + n;
        u32x4 o; o.x = cvt_pk_bf16(s[0 * 65], s[1 * 65]); o.y = cvt_pk_bf16(s[2 * 65], s[3 * 65]); o.z = cvt_pk_bf16(s[4 * 65], s[5 * 65]); o.w = cvt_pk_bf16(s[6 * 65], s[7 * 65]);
        *(u32x4*)(WT + (size_t)(n0 + n) * K + k0 + 8 * c) = o; }
    asm volatile("s_waitcnt lgkmcnt(0)" ::: "memory");
}
__device__ __forceinline__ void convert_matrix(const float* W, int K, int N, bf16_t* WT, LAS float* scr, int gw, int ngw, int lane, const float* gk = nullptr) {
    const int nitems = (K / 64) * (N / 64);
    for (int it = gw; it < nitems; it += ngw) transpose_item(W, K, N, WT, scr, it, lane, gk);
}

__device__ __forceinline__ void norm_row(const float* xrow, const float* g, bf16_t* orow, float* xcopy, int lane) {
    f32x4 v[8]; float s = 0.f;
#pragma unroll
    for (int j = 0; j < 4; ++j) { v[2 * j] = ((const f32x4*)xrow)[2 * (lane + 64 * j)]; v[2 * j + 1] = ((const f32x4*)xrow)[2 * (lane + 64 * j) + 1]; }
#pragma unroll
    for (int j = 0; j < 8; ++j) s += (v[j][0] * v[j][0] + v[j][1] * v[j][1]) + (v[j][2] * v[j][2] + v[j][3] * v[j][3]);
    if (xcopy) {
#pragma unroll
        for (int j = 0; j < 4; ++j) { ((f32x4*)xcopy)[2 * (lane + 64 * j)] = v[2 * j]; ((f32x4*)xcopy)[2 * (lane + 64 * j) + 1] = v[2 * j + 1]; } }
    const float rinv = 1.0f / sqrtf(wave_sum(s) * (1.f / D) + EPS);
#pragma unroll
    for (int j = 0; j < 4; ++j) { const f32x4 g0 = ((const f32x4*)g)[2 * (lane + 64 * j)], g1 = ((const f32x4*)g)[2 * (lane + 64 * j) + 1]; const f32x4 a = v[2 * j], c = v[2 * j + 1];
        u32x4 w; w.x = cvt_pk_bf16(a[0] * rinv * g0[0], a[1] * rinv * g0[1]); w.y = cvt_pk_bf16(a[2] * rinv * g0[2], a[3] * rinv * g0[3]);
        w.z = cvt_pk_bf16(c[0] * rinv * g1[0], c[1] * rinv * g1[1]); w.w = cvt_pk_bf16(c[2] * rinv * g1[2], c[3] * rinv * g1[3]);
        ((u32x4*)orow)[lane + 64 * j] = w; }
}
__device__ __forceinline__ float rinv_row_bf16(const bf16_t* erow, int lane) {
    float s = 0.f;
#pragma unroll
    for (int j = 0; j < 4; ++j) { const u32x4 w = ((const u32x4*)erow)[lane + 64 * j];
        const float a0 = bflo(w.x), a1 = bfhi(w.x), a2 = bflo(w.y), a3 = bfhi(w.y), a4 = bflo(w.z), a5 = bfhi(w.z), a6 = bflo(w.w), a7 = bfhi(w.w);
        s += (a0 * a0 + a1 * a1) + (a2 * a2 + a3 * a3) + (a4 * a4 + a5 * a5) + (a6 * a6 + a7 * a7); }
    return 1.0f / sqrtf(wave_sum(s) * (1.f / D) + EPS);
}
__device__ __forceinline__ void conv_p_row(const float* prow, bf16_t* orow, int lane) {
    const f32x4 v = ((const f32x4*)prow)[lane]; u32x2 w; w.x = cvt_pk_bf16(v[0], v[1]); w.y = cvt_pk_bf16(v[2], v[3]); ((u32x2*)orow)[lane] = w;
}

__device__ __forceinline__ void vt_item(LAS unsigned char* lds, const bf16_t* src, int sstride, bf16_t* vt_rows, int tok0) {
    int tid = threadIdx.x; asm volatile("" : "+v"(tid));
    constexpr int TROW = 272;
#pragma unroll
    for (int i = 0; i < 2; ++i) { const int cid = tid + i * 512, row = cid >> 4, cc = cid & 15;
        const u32x4 v = *(const u32x4*)(src + (size_t)row * sstride + cc * 8);
        *(LAS u32x4*)(lds + row * TROW + cc * 16) = v; }
    __syncthreads();
#pragma unroll
    for (int i = 0; i < 2; ++i) { const int wid2 = tid + i * 512, d = wid2 >> 3, ck = wid2 & 7;
        unsigned short e[8];
#pragma unroll
        for (int j = 0; j < 8; ++j) { const int quad = (ck & 1) * 2 + (j >> 2); const int q2 = (quad == 1) ? 2 : (quad == 2 ? 1 : quad); const int t = (ck >> 1) * 16 + q2 * 4 + (j & 3);
            e[j] = *(const LAS unsigned short*)(lds + t * TROW + d * 2); }
        u32x4 o; o.x = e[0] | ((unsigned)e[1] << 16); o.y = e[2] | ((unsigned)e[3] << 16); o.z = e[4] | ((unsigned)e[5] << 16); o.w = e[6] | ((unsigned)e[7] << 16);
        *(u32x4*)(vt_rows + (size_t)d * M + tok0 + ck * 8) = o; }
    __syncthreads();
}

__device__ __forceinline__ int crow(int r, int hi) { return (r & 3) + 8 * (r >> 2) + 4 * hi; }
template <int DQK> struct AG { static constexpr int KROW = DQK * 2 + 16, KBUF = 64 * KROW, VROW = 144, VBUF = 128 * VROW, VOFF = 2 * KBUF, KC = (64 * DQK / 8) / 512, RPB_OFF = 2 * KBUF + 3 * VBUF; };

template <int DQK, int MODE>
__device__ __forceinline__ void attn_unit(LAS unsigned char* lds, const bf16_t* qptr, const bf16_t* kbase, int kstride, const bf16_t* vtbase,
                                          int tile_lo, int tile_hi, int wlo, int whi, int a0  , int a1  ,
                                          float m_init, float l_init, bf16_t* optr) {
    typedef AG<DQK> G;
    int tid = threadIdx.x; asm volatile("" : "+v"(tid));
    const int lane = tid & 63, r32 = lane & 31, hh = lane >> 5;
    bf16x8 qf[DQK / 16];
#pragma unroll
    for (int dc = 0; dc < DQK / 16; ++dc) qf[dc] = *(const bf16x8*)(qptr + dc * 16 + hh * 8);
    f32x16 O[4];
#pragma unroll
    for (int i = 0; i < 4; ++i)
#pragma unroll
        for (int j = 0; j < 16; ++j) O[i][j] = 0.f;
    float m = m_init, l = l_init;
    const int nt = tile_hi - tile_lo;
    u32x4 kreg[G::KC], vreg[2];
    int krow_[G::KC], kcc_[G::KC];
#pragma unroll
    for (int i = 0; i < G::KC; ++i) { const int cid = tid + i * 512; krow_[i] = cid / (DQK / 8); kcc_[i] = cid % (DQK / 8); }
#define ATT_LOAD(tile) do { const size_t key0 = (size_t)(tile) * 64; \
        _Pragma("unroll") for (int i = 0; i < G::KC; ++i) kreg[i] = *(const u32x4*)(kbase + (key0 + krow_[i]) * kstride + kcc_[i] * 8); \
        _Pragma("unroll") for (int i = 0; i < 2; ++i) { const int cid = tid + i * 512; vreg[i] = *(const u32x4*)(vtbase + (size_t)(cid >> 3) * M + key0 + (cid & 7) * 8); } } while (0)
#define ATT_WRITE(kslot, vslot) do { LAS unsigned char* kb_ = lds + (kslot) * G::KBUF; LAS unsigned char* vb_ = lds + G::VOFF + (vslot) * G::VBUF; \
        _Pragma("unroll") for (int i = 0; i < G::KC; ++i) *(LAS u32x4*)(kb_ + krow_[i] * G::KROW + kcc_[i] * 16) = kreg[i]; \
        _Pragma("unroll") for (int i = 0; i < 2; ++i) { const int cid = tid + i * 512; *(LAS u32x4*)(vb_ + (cid >> 3) * G::VROW + (cid & 7) * 16) = vreg[i]; } } while (0)
#define ATT_PV(vslot) do { const LAS unsigned char* vb = lds + G::VOFF + (vslot) * G::VBUF; \
        _Pragma("unroll") for (int db = 0; db < 4; ++db) _Pragma("unroll") for (int ks = 0; ks < 4; ++ks) { \
            const bf16x8 va = *(const LAS bf16x8*)(vb + (db * 32 + r32) * G::VROW + ks * 32 + hh * 16); \
            O[db] = __builtin_amdgcn_mfma_f32_32x32x16_bf16(va, pf[ks], O[db], 0, 0, 0); } } while (0)
    const bool late = __builtin_amdgcn_readfirstlane(tid >> 6) >= 4;
    bf16x8 pf[4]; bool have_pf = false; int vprev = 0;
#pragma unroll
    for (int i = 0; i < 4; ++i) pf[i] = (bf16x8){0, 0, 0, 0, 0, 0, 0, 0};
    ATT_LOAD(tile_lo); ATT_WRITE(0, 0);
    __syncthreads();
    int vcur = 0;
    for (int it = 0; it < nt; ++it) {
        const int tile = tile_lo + it, buf = it & 1;
        const int vnext = (vcur == 2) ? 0 : vcur + 1;
        if (it + 1 < nt) ATT_LOAD(tile + 1);
        if (late && have_pf) { ATT_PV(vprev); have_pf = false; }
        if (tile >= wlo && tile < whi) {
            const LAS unsigned char* kb = lds + buf * G::KBUF;
            f32x16 S0, S1;
#pragma unroll
            for (int j = 0; j < 16; ++j) { S0[j] = 0.f; S1[j] = 0.f; }
#pragma unroll
            for (int dc = 0; dc < DQK / 16; ++dc) {
                const bf16x8 ka = *(const LAS bf16x8*)(kb + r32 * G::KROW + dc * 32 + hh * 16);
                const bf16x8 kb2 = *(const LAS bf16x8*)(kb + (32 + r32) * G::KROW + dc * 32 + hh * 16);
                S0 = __builtin_amdgcn_mfma_f32_32x32x16_bf16(ka, qf[dc], S0, 0, 0, 0);
                S1 = __builtin_amdgcn_mfma_f32_32x32x16_bf16(kb2, qf[dc], S1, 0, 0, 0);
            }
            if (MODE == 1) {
                const LAS float* rpbL = (const LAS float*)(lds + G::RPB_OFF);
                const int c = a0; int cs = c - 8; cs = cs < 0 ? 0 : (cs > 48 ? 48 : cs);
                const LAS float* rrow = rpbL + (tile + a1) * 31;
                int cb = 4 * hh + 15 - c, vb_ = 4 * hh - cs; asm volatile("" : "+v"(cb), "+v"(vb_));
                float bb0[16], bb1[16];
#pragma unroll
                for (int j = 0; j < 16; ++j) {
                    const int kk = (j & 3) + 8 * (j >> 2);
                    int i0 = kk + cb; i0 = i0 < 0 ? 0 : (i0 > 30 ? 30 : i0); int i1 = kk + 32 + cb; i1 = i1 < 0 ? 0 : (i1 > 30 ? 30 : i1);
                    bb0[j] = rrow[i0]; bb1[j] = rrow[i1];
                }
#pragma unroll
                for (int j = 0; j < 16; ++j) asm volatile("" : "+v"(bb0[j]), "+v"(bb1[j]));
#pragma unroll
                for (int j = 0; j < 16; ++j) {
                    const int kk = (j & 3) + 8 * (j >> 2);
                    S0[j] = ((unsigned)(kk + vb_) < 16u) ? S0[j] + bb0[j] : -INFINITY;
                    S1[j] = ((unsigned)(kk + 32 + vb_) < 16u) ? S1[j] + bb1[j] : -INFINITY;
                }
            }
            if (MODE == 2) {
                const int dbase = tile * 64 - a0;
#pragma unroll
                for (int j = 0; j < 16; ++j) {
                    const int d0 = dbase + crow(j, hh), d1 = d0 + 32;
                    S0[j] = (d0 >= -128 && d0 <= 128) ? S0[j] : -INFINITY;
                    S1[j] = (d1 >= -128 && d1 <= 128) ? S1[j] : -INFINITY;
                }
            }
            float pmax = S0[0];
#pragma unroll
            for (int j = 1; j < 16; ++j) pmax = fmaxf(pmax, S0[j]);
#pragma unroll
            for (int j = 0; j < 16; ++j) pmax = fmaxf(pmax, S1[j]);
            { auto rr = __builtin_amdgcn_permlane32_swap(__float_as_uint(pmax), __float_as_uint(pmax), false, false); pmax = fmaxf(__uint_as_float(rr[0]), __uint_as_float(rr[1])); }
            if (!__all(pmax - m <= 8.0f)) {
                const float mn2 = fmaxf(m, pmax); const float alpha = __builtin_amdgcn_exp2f(m - mn2); m = mn2; l *= alpha;
#pragma unroll
                for (int i = 0; i < 4; ++i)
#pragma unroll
                    for (int j = 0; j < 16; ++j) O[i][j] *= alpha;
            }
            const float mn = m;
            float ps = 0.f;
#pragma unroll
            for (int j = 0; j < 16; ++j) { S0[j] = __builtin_amdgcn_exp2f(S0[j] - mn); S1[j] = __builtin_amdgcn_exp2f(S1[j] - mn); ps += S0[j] + S1[j]; }
            l += ps;
            { u32x4 w;
              w.x = cvt_pk_bf16(S0[0], S0[1]); w.y = cvt_pk_bf16(S0[2], S0[3]); w.z = cvt_pk_bf16(S0[4], S0[5]); w.w = cvt_pk_bf16(S0[6], S0[7]); pf[0] = *(bf16x8*)&w;
              w.x = cvt_pk_bf16(S0[8], S0[9]); w.y = cvt_pk_bf16(S0[10], S0[11]); w.z = cvt_pk_bf16(S0[12], S0[13]); w.w = cvt_pk_bf16(S0[14], S0[15]); pf[1] = *(bf16x8*)&w;
              w.x = cvt_pk_bf16(S1[0], S1[1]); w.y = cvt_pk_bf16(S1[2], S1[3]); w.z = cvt_pk_bf16(S1[4], S1[5]); w.w = cvt_pk_bf16(S1[6], S1[7]); pf[2] = *(bf16x8*)&w;
              w.x = cvt_pk_bf16(S1[8], S1[9]); w.y = cvt_pk_bf16(S1[10], S1[11]); w.z = cvt_pk_bf16(S1[12], S1[13]); w.w = cvt_pk_bf16(S1[14], S1[15]); pf[3] = *(bf16x8*)&w; }
            if (!late) ATT_PV(vcur); else { have_pf = true; vprev = vcur; }
        }
        if (it + 1 < nt) ATT_WRITE(buf ^ 1, vnext);
        vcur = vnext;
        __syncthreads();
    }
    if (late && have_pf) ATT_PV(vprev);
#undef ATT_LOAD
#undef ATT_WRITE
#undef ATT_PV
    { auto rr = __builtin_amdgcn_permlane32_swap(__float_as_uint(l), __float_as_uint(l), false, false); l = __uint_as_float(rr[0]) + __uint_as_float(rr[1]); }
    const float inv = 1.0f / l;
#pragma unroll
    for (int db = 0; db < 4; ++db)
#pragma unroll
        for (int t = 0; t < 2; ++t) {
            const unsigned x0 = cvt_pk_bf16(O[db][8 * t + 0] * inv, O[db][8 * t + 1] * inv), x1 = cvt_pk_bf16(O[db][8 * t + 2] * inv, O[db][8 * t + 3] * inv);
            const unsigned y0 = cvt_pk_bf16(O[db][8 * t + 4] * inv, O[db][8 * t + 5] * inv), y1 = cvt_pk_bf16(O[db][8 * t + 6] * inv, O[db][8 * t + 7] * inv);
            auto r0 = __builtin_amdgcn_permlane32_swap(x0, y0, false, false); auto r1 = __builtin_amdgcn_permlane32_swap(x1, y1, false, false);
            u32x4 w = {r0[0], r1[0], r0[1], r1[1]};
            *(u32x4*)(optr + db * 32 + 16 * t + 8 * hh) = w;
        }
    __syncthreads();
}

__global__ void __launch_bounds__(NTHREADS, 2) fwd_megakernel(Params P) {
    extern __shared__ __attribute__((aligned(16))) unsigned char lds_raw[];
    LAS unsigned char* lds = (LAS unsigned char*)lds_raw;
    cg::grid_group grid = cg::this_grid();
    if (threadIdx.x < 4) ((LAS unsigned*)(lds + LDS_BYTES - 16))[threadIdx.x] = 0u;
    __syncthreads();
    XcdBarrier xbar;
    { KARG(kpb); xbar = xcd_barrier_post((unsigned*)(kpb->ws + WS_BAR), (volatile LAS unsigned*)(lds + LDS_BYTES - 16)); }
#define GRID_SYNC() xcd_barrier(xbar)
    { KARG(kpc); if (kpc->ws == nullptr) grid.sync(); }
#define PHASE_VARS \
    KARG(kp); unsigned char* ws = kp->ws; float* X = kp->out; \
    int tid = threadIdx.x; asm volatile("" : "+v"(tid)); const int lane = tid & 63, wave = __builtin_amdgcn_readfirstlane(tid >> 6); \
    int bid = blockIdx.x; asm volatile("" : "+s"(bid)); const int G = gridDim.x; const int gw = bid * NWAVES + wave, ngw = G * NWAVES; \
    bf16_t* H = (bf16_t*)(ws + WS_H); bf16_t* E = (bf16_t*)(ws + WS_E); bf16_t* PB = (bf16_t*)(ws + WS_PB); \
    float* SS = (float*)(ws + WS_SS); float* ROPE64 = (float*)(ws + WS_ROPE64); float* ROPE128 = (float*)(ws + WS_ROPE128); \
    LAS float* scr = (LAS float*)(lds + wave * 16640); \
    (void)X; (void)H; (void)E; (void)PB; (void)SS; (void)ROPE64; (void)ROPE128; (void)scr; (void)gw; (void)ngw; (void)lane; (void)G

    if (PH(0)) {
        PHASE_VARS;
        _Pragma("unroll 1") for (int rep_ = 0; rep_ < REP_CONV; ++rep_) {
        convert_matrix(kp->in[I_PLE_PROJ], 256, D, (bf16_t*)(ws + W_PROJ), scr, gw, ngw, lane);
        convert_matrix(kp->in[I_EV_WIN], D, EV_IN, (bf16_t*)(ws + W_EVIN), scr, gw, ngw, lane);
        convert_matrix(kp->in[I_WQB], 512, 1536, (bf16_t*)(ws + W_QB), scr, gw, ngw, lane);
        convert_matrix(kp->in[I_WKVB], 256, 2048, (bf16_t*)(ws + W_KVB), scr, gw, ngw, lane);
        convert_matrix(kp->in[I_EV_WOUT], D, D, (bf16_t*)(ws + W_EVOUT), scr, gw, ngw, lane);
        }
        for (int i = bid * NTHREADS + tid; i < 4096 * 32; i += G * NTHREADS) { const int pos = i >> 5, f = i & 31;
            const float inv = exp2f(-(float)(2 * f) / 64.0f * 13.287712379549449f);
            double rev = (double)pos * (double)inv * 0.15915494309189535; rev -= floor(rev);
            ROPE64[i] = __builtin_amdgcn_cosf((float)rev); ROPE64[4096 * 32 + i] = __builtin_amdgcn_sinf((float)rev); }
        for (int i = bid * NTHREADS + tid; i < 4096 * 64; i += G * NTHREADS) { const int pos = i >> 6, f = i & 63;
            const float inv = exp2f(-(float)(2 * f) / 128.0f * 13.287712379549449f);
            double rev = (double)pos * (double)inv * 0.15915494309189535; rev -= floor(rev);
            ROPE128[i] = __builtin_amdgcn_cosf((float)rev); ROPE128[4096 * 64 + i] = __builtin_amdgcn_sinf((float)rev); }
        _Pragma("unroll 1") for (int rp_ = 0; rp_ < REP_PREP; ++rp_) for (int row = gw; row < M; row += ngw) {
            const float* xr = row < 8192 ? kp->in[I_XP] + (size_t)row * D : kp->in[I_XS] + (size_t)(row - 8192) * D;
            norm_row(xr, kp->in[I_ATTN_NORM], H + (size_t)row * D, nullptr, lane);
            const float* pr = row < 8192 ? kp->in[I_PP] + (size_t)row * 256 : kp->in[I_PS] + (size_t)(row - 8192) * 256;
            conv_p_row(pr, PB + (size_t)row * 256, lane);
            conv_p_row(pr + (size_t)8192 * 256, (bf16_t*)(ws + WS_PB1) + (size_t)row * 256, lane);
        }
        for (int i = bid * NTHREADS + tid; i < 5 * M; i += G * NTHREADS) SS[i] = 0.f;
    }
    GRID_SYNC();

    if (PH(1)) { PHASE_VARS; pg8::EpiBf16<0> Ep{(bf16_t*)(ws + B_Z), EV_INP, nullptr, nullptr}; pg8::run_gemm(lds, H, (const bf16_t*)(ws + W_EVIN), EV_INP, D, Ep); }
    GRID_SYNC();

    if (PH(2)) {
        PHASE_VARS;
        const bf16_t* Z = (const bf16_t*)(ws + B_Z);
        bf16_t* QN = (bf16_t*)(ws + B_QN); bf16_t* KVN = (bf16_t*)(ws + B_KVN); bf16_t* KR = (bf16_t*)(ws + B_KR);
        bf16_t* NQ = (bf16_t*)(ws + B_NQ); bf16_t* NK = (bf16_t*)(ws + B_NK); bf16_t* NVT = (bf16_t*)(ws + B_NVT);
        const float CNA = 0.08838834764831845f * LOG2E;
        _Pragma("unroll 1") for (int rp_ = 0; rp_ < REP_PREP; ++rp_) for (int tok = gw; tok < M; tok += ngw) {
            const bf16_t* z = Z + (size_t)tok * EV_INP; const int pos = tok_pos(tok);
            { const u32x4 w = *(const u32x4*)(z + 8 * lane);
              float v[8] = {bflo(w.x), bfhi(w.x), bflo(w.y), bfhi(w.y), bflo(w.z), bfhi(w.z), bflo(w.w), bfhi(w.w)}; float s = 0.f;
#pragma unroll
              for (int j = 0; j < 8; ++j) s += v[j] * v[j];
              const float ri = 1.0f / sqrtf(wave_sum(s) * (1.f / 512.f) + EPS); const float* g = kp->in[I_QA_NORM] + 8 * lane;
              u32x4 o; o.x = cvt_pk_bf16(v[0] * ri * g[0], v[1] * ri * g[1]); o.y = cvt_pk_bf16(v[2] * ri * g[2], v[3] * ri * g[3]); o.z = cvt_pk_bf16(v[4] * ri * g[4], v[5] * ri * g[5]); o.w = cvt_pk_bf16(v[6] * ri * g[6], v[7] * ri * g[7]);
              *(u32x4*)(QN + (size_t)tok * 512 + 8 * lane) = o; }
            { const u32x2 w = *(const u32x2*)(z + 512 + 4 * lane);
              float v[4] = {bflo(w.x), bfhi(w.x), bflo(w.y), bfhi(w.y)}; const float s = (v[0] * v[0] + v[1] * v[1]) + (v[2] * v[2] + v[3] * v[3]);
              const float ri = 1.0f / sqrtf(wave_sum(s) * (1.f / 256.f) + EPS); const float* g = kp->in[I_KVA_NORM] + 4 * lane;
              u32x2 o; o.x = cvt_pk_bf16(v[0] * ri * g[0], v[1] * ri * g[1]); o.y = cvt_pk_bf16(v[2] * ri * g[2], v[3] * ri * g[3]);
              *(u32x2*)(KVN + (size_t)tok * 256 + 4 * lane) = o; }
            { const float v = bf2f(z[768 + lane]); const float ri = 1.0f / sqrtf(wave_sum(v * v) * (1.f / 64.f) + EPS);
              const float y = v * ri * kp->in[I_KROPE_NORM][lane]; const float yp = __shfl_xor(y, 32);
              const float c = ROPE64[pos * 32 + (lane & 31)], s = ROPE64[4096 * 32 + pos * 32 + (lane & 31)];
              const float o = lane < 32 ? y * c - yp * s : y * c + yp * s;
              KR[(size_t)tok * 64 + lane] = f2bf(o); }
#pragma unroll
            for (int p = 0; p < 2; ++p) {
                const int d0 = 8 * (lane & 15);
                { const u32x4 w = *(const u32x4*)(z + 832 + p * 512 + 8 * lane);
                  float v[8] = {bflo(w.x), bfhi(w.x), bflo(w.y), bfhi(w.y), bflo(w.z), bfhi(w.z), bflo(w.w), bfhi(w.w)}; float s = 0.f;
#pragma unroll
                  for (int j = 0; j < 8; ++j) s += v[j] * v[j];
                  const float ri = CNA / sqrtf(group_sum<16>(s) * (1.f / 128.f) + EPS); const float* g = kp->in[I_NAQ_NORM] + d0;
                  u32x4 o; o.x = cvt_pk_bf16(v[0] * ri * g[0], v[1] * ri * g[1]); o.y = cvt_pk_bf16(v[2] * ri * g[2], v[3] * ri * g[3]); o.z = cvt_pk_bf16(v[4] * ri * g[4], v[5] * ri * g[5]); o.w = cvt_pk_bf16(v[6] * ri * g[6], v[7] * ri * g[7]);
                  *(u32x4*)(NQ + (size_t)tok * 1024 + p * 512 + 8 * lane) = o; }
                { const u32x4 w = *(const u32x4*)(z + 1856 + p * 512 + 8 * lane);
                  float v[8] = {bflo(w.x), bfhi(w.x), bflo(w.y), bfhi(w.y), bflo(w.z), bfhi(w.z), bflo(w.w), bfhi(w.w)}; float s = 0.f;
#pragma unroll
                  for (int j = 0; j < 8; ++j) s += v[j] * v[j];
                  const float ri = 1.0f / sqrtf(group_sum<16>(s) * (1.f / 128.f) + EPS); const float* g = kp->in[I_NAK_NORM] + d0;
                  u32x4 o; o.x = cvt_pk_bf16(v[0] * ri * g[0], v[1] * ri * g[1]); o.y = cvt_pk_bf16(v[2] * ri * g[2], v[3] * ri * g[3]); o.z = cvt_pk_bf16(v[4] * ri * g[4], v[5] * ri * g[5]); o.w = cvt_pk_bf16(v[6] * ri * g[6], v[7] * ri * g[7]);
                  *(u32x4*)(NK + (size_t)tok * 1024 + p * 512 + 8 * lane) = o; }
            }
        }
        __syncthreads();
        _Pragma("unroll 1") for (int rp_ = 0; rp_ < REP_PREP; ++rp_) for (int it = bid; it < 256 * 8; it += G) { const int tt = it >> 3, h = it & 7;
            vt_item(lds, Z + (size_t)(tt * 64) * EV_INP + 2880 + h * 128, EV_INP, NVT + (size_t)(h * 128) * M, tt * 64); }
    }
    GRID_SYNC();

    if (PH(3)) { PHASE_VARS; pg8::EpiBf16<0> Ep{(bf16_t*)(ws + B_Q1), 1536, nullptr, nullptr}; pg8::run_gemm(lds, (const bf16_t*)(ws + B_QN), (const bf16_t*)(ws + W_QB), 1536, 512, Ep); }
    if (PH(3)) { PHASE_VARS; pg8::EpiBf16<0> Ep{(bf16_t*)(ws + B_KV1), 2048, nullptr, nullptr}; pg8::run_gemm(lds, (const bf16_t*)(ws + B_KVN), (const bf16_t*)(ws + W_KVB), 2048, 256, Ep); }
    GRID_SYNC();

    if (PH(4)) {
        PHASE_VARS;
        const bf16_t* Q1 = (const bf16_t*)(ws + B_Q1); const bf16_t* KV1 = (const bf16_t*)(ws + B_KV1); const bf16_t* KR = (const bf16_t*)(ws + B_KR);
        bf16_t* QM = (bf16_t*)(ws + HE_QM); bf16_t* KM = (bf16_t*)(ws + HE_KM); bf16_t* VTM = (bf16_t*)(ws + HE_VTM);
        const float CM = 0.07216878364870323f * LOG2E;
        const int hq = lane >> 3, sl = lane & 7;
        float gqn[16], gkn[16], gqr[8];
#pragma unroll
        for (int j = 0; j < 16; ++j) { gqn[j] = kp->in[I_QNOPE_NORM][sl * 16 + j]; gkn[j] = kp->in[I_KNOPE_NORM][sl * 16 + j]; }
#pragma unroll
        for (int j = 0; j < 8; ++j) gqr[j] = kp->in[I_QROPE_NORM][sl * 8 + j];
        _Pragma("unroll 1") for (int rp_ = 0; rp_ < REP_PREP; ++rp_) for (int tok = gw; tok < M; tok += ngw) {
            const int pos = tok_pos(tok);
            const bf16_t* q = Q1 + (size_t)tok * 1536 + hq * 192; bf16_t* qo = QM + (size_t)tok * 1536 + hq * 192;
            const bf16_t* k = KV1 + (size_t)tok * 2048 + hq * 256; bf16_t* ko = KM + (size_t)tok * 1536 + hq * 192;
            const u32x4 qa = *(const u32x4*)(q + sl * 16), qb = *(const u32x4*)(q + sl * 16 + 8), qr = *(const u32x4*)(q + 128 + sl * 8);
            const u32x4 ka = *(const u32x4*)(k + sl * 16), kb = *(const u32x4*)(k + sl * 16 + 8), krv = *(const u32x4*)(KR + (size_t)tok * 64 + sl * 8);
            const f32x4 c0 = *(const f32x4*)(ROPE64 + pos * 32 + (sl & 3) * 8), c1 = *(const f32x4*)(ROPE64 + pos * 32 + (sl & 3) * 8 + 4);
            const f32x4 s0 = *(const f32x4*)(ROPE64 + 4096 * 32 + pos * 32 + (sl & 3) * 8), s1 = *(const f32x4*)(ROPE64 + 4096 * 32 + pos * 32 + (sl & 3) * 8 + 4);
            { float v[16] = {bflo(qa.x), bfhi(qa.x), bflo(qa.y), bfhi(qa.y), bflo(qa.z), bfhi(qa.z), bflo(qa.w), bfhi(qa.w), bflo(qb.x), bfhi(qb.x), bflo(qb.y), bfhi(qb.y), bflo(qb.z), bfhi(qb.z), bflo(qb.w), bfhi(qb.w)};
              float ss = 0.f;
#pragma unroll
              for (int j = 0; j < 16; ++j) ss += v[j] * v[j];
              const float ri = CM / sqrtf(group_sum<8>(ss) * (1.f / 128.f) + EPS);
              u32x4 o0, o1;
              o0.x = cvt_pk_bf16(v[0] * ri * gqn[0], v[1] * ri * gqn[1]); o0.y = cvt_pk_bf16(v[2] * ri * gqn[2], v[3] * ri * gqn[3]); o0.z = cvt_pk_bf16(v[4] * ri * gqn[4], v[5] * ri * gqn[5]); o0.w = cvt_pk_bf16(v[6] * ri * gqn[6], v[7] * ri * gqn[7]);
              o1.x = cvt_pk_bf16(v[8] * ri * gqn[8], v[9] * ri * gqn[9]); o1.y = cvt_pk_bf16(v[10] * ri * gqn[10], v[11] * ri * gqn[11]); o1.z = cvt_pk_bf16(v[12] * ri * gqn[12], v[13] * ri * gqn[13]); o1.w = cvt_pk_bf16(v[14] * ri * gqn[14], v[15] * ri * gqn[15]);
              *(u32x4*)(qo + sl * 16) = o0; *(u32x4*)(qo + sl * 16 + 8) = o1; }
            { float v[8] = {bflo(qr.x), bfhi(qr.x), bflo(qr.y), bfhi(qr.y), bflo(qr.z), bfhi(qr.z), bflo(qr.w), bfhi(qr.w)};
              const float cc[8] = {c0[0], c0[1], c0[2], c0[3], c1[0], c1[1], c1[2], c1[3]}, sn[8] = {s0[0], s0[1], s0[2], s0[3], s1[0], s1[1], s1[2], s1[3]};
              float ss = 0.f;
#pragma unroll
              for (int j = 0; j < 8; ++j) ss += v[j] * v[j];
              const float ri = 1.0f / sqrtf(group_sum<8>(ss) * (1.f / 64.f) + EPS);
              float o[8];
#pragma unroll
              for (int j = 0; j < 8; ++j) { const float y = v[j] * ri * gqr[j]; const float yp = __shfl_xor(y, 4); o[j] = (sl < 4 ? y * cc[j] - yp * sn[j] : y * cc[j] + yp * sn[j]) * CM; }
              u32x4 w; w.x = cvt_pk_bf16(o[0], o[1]); w.y = cvt_pk_bf16(o[2], o[3]); w.z = cvt_pk_bf16(o[4], o[5]); w.w = cvt_pk_bf16(o[6], o[7]);
              *(u32x4*)(qo + 128 + sl * 8) = w; }
            { float v[16] = {bflo(ka.x), bfhi(ka.x), bflo(ka.y), bfhi(ka.y), bflo(ka.z), bfhi(ka.z), bflo(ka.w), bfhi(ka.w), bflo(kb.x), bfhi(kb.x), bflo(kb.y), bfhi(kb.y), bflo(kb.z), bfhi(kb.z), bflo(kb.w), bfhi(kb.w)};
              float ss = 0.f;
#pragma unroll
              for (int j = 0; j < 16; ++j) ss += v[j] * v[j];
              const float ri = 1.0f / sqrtf(group_sum<8>(ss) * (1.f / 128.f) + EPS);
              u32x4 o0, o1;
              o0.x = cvt_pk_bf16(v[0] * ri * gkn[0], v[1] * ri * gkn[1]); o0.y = cvt_pk_bf16(v[2] * ri * gkn[2], v[3] * ri * gkn[3]); o0.z = cvt_pk_bf16(v[4] * ri * gkn[4], v[5] * ri * gkn[5]); o0.w = cvt_pk_bf16(v[6] * ri * gkn[6], v[7] * ri * gkn[7]);
              o1.x = cvt_pk_bf16(v[8] * ri * gkn[8], v[9] * ri * gkn[9]); o1.y = cvt_pk_bf16(v[10] * ri * gkn[10], v[11] * ri * gkn[11]); o1.z = cvt_pk_bf16(v[12] * ri * gkn[12], v[13] * ri * gkn[13]); o1.w = cvt_pk_bf16(v[14] * ri * gkn[14], v[15] * ri * gkn[15]);
              *(u32x4*)(ko + sl * 16) = o0; *(u32x4*)(ko + sl * 16 + 8) = o1; }
            *(u32x4*)(ko + 128 + sl * 8) = krv;
        }
        __syncthreads();
        _Pragma("unroll 1") for (int rp_ = 0; rp_ < REP_PREP; ++rp_) for (int it = bid; it < 256 * 8; it += G) { const int tt = it >> 3, h = it & 7;
            vt_item(lds, KV1 + (size_t)(tt * 64) * 2048 + h * 256 + 128, 2048, VTM + (size_t)(h * 128) * M, tt * 64); }
    }
    GRID_SYNC();

    if (PH(5)) {
        PHASE_VARS;
        const bf16_t* QM = (const bf16_t*)(ws + HE_QM); const bf16_t* KM = (const bf16_t*)(ws + HE_KM); const bf16_t* VTM = (const bf16_t*)(ws + HE_VTM);
        const bf16_t* NQ = (const bf16_t*)(ws + B_NQ); const bf16_t* NK = (const bf16_t*)(ws + B_NK); const bf16_t* NVT = (const bf16_t*)(ws + B_NVT);
        bf16_t* OC = (bf16_t*)(ws + B_OCAT0);
        const int cslot = (G == 256) ? ((bid >> 3) % 5) : 0; int aunit = 0;
#define A1_CONV() do { if (aunit == cslot) { __syncthreads(); \
            convert_matrix(kp->in[I_WUP], D, DFF, (bf16_t*)(ws + W_UP), scr, gw, ngw, lane, kp->in[I_MLP_NORM]); \
            convert_matrix(kp->in[I_WDOWN], DFF, D, (bf16_t*)(ws + W_DOWN), scr, gw, ngw, lane); \
            convert_matrix(kp->in[I_PLE_GATE], D, D, (bf16_t*)(ws + W_GATE), scr, gw, ngw, lane); \
            __syncthreads(); } ++aunit; } while (0)
        _Pragma("unroll 1") for (int rep_ = 0; rep_ < REP_MLA; ++rep_)
        for (int u = bid; u < 512; u += G) {
            A1_CONV();
            int seqbase, T, h, qb;
            int uu = u; if (G == 256) { const int b = u & 255, x = b & 7, j = b >> 3; uu = (u < 256) ? (x * 2 + (j >> 4)) * 16 + (j & 15) : 256 + (x * 4 + (j >> 3)) * 8 + (j & 7); }
            if (uu < 256) { const int s = uu >> 7; seqbase = s * 4096; T = 4096; h = (uu >> 4) & 7; qb = uu & 15; }
            else { const int v = uu - 256; const int s = v >> 6; seqbase = 8192 + s * 2048; T = 2048; h = (v >> 3) & 7; qb = v & 7; }
            const int tq = seqbase + qb * 256 + wave * 32 + (lane & 31);
            const int t0 = seqbase >> 6, t1 = (seqbase + T) >> 6;
            attn_unit<192, 0>(lds, QM + (size_t)tq * 1536 + h * 192, KM + h * 192, 1536, VTM + (size_t)(h * 128) * M, t0, t1, t0, t1, 0, 0, -1e30f, 0.f, OC + (size_t)tq * 2048 + h * 128);
        }
        _Pragma("unroll 1") for (int rep_ = 0; rep_ < REP_NA; ++rep_)
        for (int u = bid; u < 512; u += G) {
            A1_CONV();
            int seqbase, rows, h, rg;
            int uu = u; if (G == 256) { const int b = u & 255, x = b & 7, j = b >> 3; uu = (u < 256) ? (x * 2 + (j >> 4)) * 16 + (j & 15) : 256 + (x * 4 + (j >> 3)) * 8 + (j & 7); }
            if (uu < 256) { const int s = uu >> 7; seqbase = s * 4096; rows = 64; h = (uu >> 4) & 7; rg = uu & 15; }
            else { const int v = uu - 256; const int s = v >> 6; seqbase = 8192 + s * 2048; rows = 32; h = (v >> 3) & 7; rg = v & 7; }
            { LAS float* rpbL = (LAS float*)(lds + AG<128>::RPB_OFF); for (int i = tid; i < 465; i += NTHREADS) rpbL[i] = kp->in[I_RPB][h * 465 + i] * LOG2E; }
            const int r = rg * 4 + (wave >> 1), c = (wave & 1) * 32 + (lane & 31);
            const int tq = seqbase + r * 64 + c;
            const int st0 = seqbase >> 6;
            int rs_lo = rg * 4 - 4; rs_lo = rs_lo < 0 ? 0 : (rs_lo > rows - 8 ? rows - 8 : rs_lo);
            int rs_hi = rg * 4 + 3 - 4; rs_hi = rs_hi < 0 ? 0 : (rs_hi > rows - 8 ? rows - 8 : rs_hi);
            int rs = r - 4; rs = rs < 0 ? 0 : (rs > rows - 8 ? rows - 8 : rs);
            attn_unit<128, 1>(lds, NQ + (size_t)tq * 1024 + h * 128, NK + h * 128, 1024, NVT + (size_t)(h * 128) * M, st0 + rs_lo, st0 + rs_hi + 8, st0 + rs, st0 + rs + 8, c, 7 - r - st0, -1e30f, 0.f,
                              OC + (size_t)tq * 2048 + 1024 + h * 128);
        }
        if (aunit <= cslot) { aunit = cslot; A1_CONV(); }
#undef A1_CONV
    }
    GRID_SYNC();

    if (PH(6)) { PHASE_VARS; pg8::EpiResidB Ep{nullptr, kp->in[I_XP], kp->in[I_XS], H, SS + 0 * M, nullptr}; pg8::run_gemm(lds, (const bf16_t*)(ws + B_OCAT0), (const bf16_t*)(ws + W_EVOUT), D, D, Ep); }
    if (PH(6)) { PHASE_VARS; pg8::EpiBf16<0> Ep{E, D, nullptr, SS + 3 * M}; pg8::run_gemm(lds, PB, (const bf16_t*)(ws + W_PROJ), D, 256, Ep); }
    GRID_SYNC();

    if (PH(9)) { PHASE_VARS; pg8::EpiBf16<1> Ep{(bf16_t*)(ws + B_ACT), DFF, nullptr, nullptr};
        const int ksp = (G == 256) ? ((bid >> 3) & 7) : (1 << 20);
        pg8::run_gemm(lds, H, (const bf16_t*)(ws + W_UP), DFF, D, Ep, 0, ksp);
        convert_matrix(kp->in[I_OD_WIN], D, OD_IN, (bf16_t*)(ws + W_ODIN), scr, gw, ngw, lane, kp->in[I_ATTN_NORM] + D);
        __syncthreads();
        pg8::run_gemm(lds, H, (const bf16_t*)(ws + W_UP), DFF, D, Ep, ksp, 1 << 20); }
    GRID_SYNC();
    if (PH(10)) { PHASE_VARS; pg8::EpiResidB Ep{H, nullptr, nullptr, (bf16_t*)X, nullptr, SS + 0 * M};
        pg8::run_gemm(lds, (const bf16_t*)(ws + B_ACT), (const bf16_t*)(ws + W_DOWN), D, DFF, Ep); }
    GRID_SYNC();
    if (PH(11)) { PHASE_VARS; pg8::EpiGateB Ep{(const bf16_t*)X, E, SS + 3 * M, kp->in[I_PLE_NORM], H, SS + 2 * M, nullptr};
        pg8::run_gemm(lds, (const bf16_t*)X, (const bf16_t*)(ws + W_GATE), D, D, Ep); }
    GRID_SYNC();

    if (PH(7)) {
            { PHASE_VARS; pg8::EpiBf16<0> Ep{(bf16_t*)(ws + B_Z), OD_IN, SS + 2 * M, nullptr}; pg8::run_gemm(lds, H, (const bf16_t*)(ws + W_ODIN), OD_IN, D, Ep); }
            GRID_SYNC();
            {
                PHASE_VARS;
                const bf16_t* Z3 = (const bf16_t*)(ws + B_Z); bf16_t* SQ = (bf16_t*)(ws + B_SQ); bf16_t* SK = (bf16_t*)(ws + B_SK); bf16_t* SVT = (bf16_t*)(ws + B_SVT);
                const float CS = 0.08838834764831845f * LOG2E;
                const int hs = lane >> 3, j8 = 8 * (lane & 7);
                float gq[16], gk[16];
#pragma unroll
                for (int j = 0; j < 8; ++j) { gq[j] = kp->in[I_SWAQ_NORM][j8 + j]; gq[8 + j] = kp->in[I_SWAQ_NORM][64 + j8 + j]; gk[j] = kp->in[I_SWAK_NORM][j8 + j]; gk[8 + j] = kp->in[I_SWAK_NORM][64 + j8 + j]; }
                _Pragma("unroll 1") for (int rp_ = 0; rp_ < REP_PREP; ++rp_) for (int tok = gw; tok < M; tok += ngw) {
                    const int pos = tok_pos(tok);
                    const f32x4 c0 = *(const f32x4*)(ROPE128 + pos * 64 + j8), c1 = *(const f32x4*)(ROPE128 + pos * 64 + j8 + 4);
                    const f32x4 s0 = *(const f32x4*)(ROPE128 + 4096 * 64 + pos * 64 + j8), s1 = *(const f32x4*)(ROPE128 + 4096 * 64 + pos * 64 + j8 + 4);
                    const float cc[8] = {c0[0], c0[1], c0[2], c0[3], c1[0], c1[1], c1[2], c1[3]}, sn[8] = {s0[0], s0[1], s0[2], s0[3], s1[0], s1[1], s1[2], s1[3]};
                    const bf16_t* z = Z3 + (size_t)tok * OD_IN;
#pragma unroll
                    for (int p = 0; p < 3; ++p) {
                        const int head = 8 * p + hs; const bool act = head < 20; const int hc = act ? head : 19;
                        const bf16_t* src = z + hc * 128;
                        const u32x4 w1 = *(const u32x4*)(src + j8), w2 = *(const u32x4*)(src + 64 + j8);
                        const float a[8] = {bflo(w1.x), bfhi(w1.x), bflo(w1.y), bfhi(w1.y), bflo(w1.z), bfhi(w1.z), bflo(w1.w), bfhi(w1.w)};
                        const float b[8] = {bflo(w2.x), bfhi(w2.x), bflo(w2.y), bfhi(w2.y), bflo(w2.z), bfhi(w2.z), bflo(w2.w), bfhi(w2.w)};
                        float ss = 0.f;
#pragma unroll
                        for (int j = 0; j < 8; ++j) ss += a[j] * a[j] + b[j] * b[j];
                        const bool isq = hc < 16;
                        const float ri = (isq ? CS : 1.0f) / sqrtf(group_sum<8>(ss) * (1.f / 128.f) + EPS);
                        float o1[8], o2[8];
#pragma unroll
                        for (int j = 0; j < 8; ++j) { const float y1 = a[j] * ri * (isq ? gq[j] : gk[j]), y2 = b[j] * ri * (isq ? gq[8 + j] : gk[8 + j]); o1[j] = y1 * cc[j] - y2 * sn[j]; o2[j] = y2 * cc[j] + y1 * sn[j]; }
                        u32x4 v1, v2;
                        v1.x = cvt_pk_bf16(o1[0], o1[1]); v1.y = cvt_pk_bf16(o1[2], o1[3]); v1.z = cvt_pk_bf16(o1[4], o1[5]); v1.w = cvt_pk_bf16(o1[6], o1[7]);
                        v2.x = cvt_pk_bf16(o2[0], o2[1]); v2.y = cvt_pk_bf16(o2[2], o2[3]); v2.z = cvt_pk_bf16(o2[4], o2[5]); v2.w = cvt_pk_bf16(o2[6], o2[7]);
                        bf16_t* dst = isq ? SQ + (size_t)tok * 2048 + hc * 128 : SK + (size_t)tok * 512 + (hc - 16) * 128;
                        if (act) { *(u32x4*)(dst + j8) = v1; *(u32x4*)(dst + 64 + j8) = v2; }
                    }
                }
                __syncthreads();
                _Pragma("unroll 1") for (int rp_ = 0; rp_ < REP_PREP; ++rp_) for (int it = bid; it < 256 * 4; it += G) { const int tt = it >> 2, h = it & 3;
                    vt_item(lds, Z3 + (size_t)(tt * 64) * OD_IN + 2560 + h * 128, OD_IN, SVT + (size_t)(h * 128) * M, tt * 64); }
            }
            GRID_SYNC();
            {
                PHASE_VARS;
                const bf16_t* SQ = (const bf16_t*)(ws + B_SQ); const bf16_t* SK = (const bf16_t*)(ws + B_SK); const bf16_t* SVT = (const bf16_t*)(ws + B_SVT);
                bf16_t* OC = (bf16_t*)(ws + B_OCAT1);
                const int cslot = (G == 256) ? ((bid >> 3) % 5) : 0; int aunit = 0;
#define A2_CONV() do { if (aunit == cslot) { __syncthreads(); \
                    convert_matrix(kp->in[I_OD_WOUT], D, D, (bf16_t*)(ws + W_ODOUT), scr, gw, ngw, lane); \
                    convert_matrix(kp->in[I_WUP] + (size_t)D * DFF, D, DFF, (bf16_t*)(ws + W_UP), scr, gw, ngw, lane, kp->in[I_MLP_NORM] + D); \
                    convert_matrix(kp->in[I_WDOWN] + (size_t)D * DFF, DFF, D, (bf16_t*)(ws + W_DOWN), scr, gw, ngw, lane); \
                    convert_matrix(kp->in[I_PLE_GATE] + (size_t)D * D, D, D, (bf16_t*)(ws + W_GATE1), scr, gw, ngw, lane); \
                    convert_matrix(kp->in[I_PLE_PROJ] + (size_t)256 * D, 256, D, (bf16_t*)(ws + W_PROJ), scr, gw, ngw, lane); \
                    __syncthreads(); } ++aunit; } while (0)
                _Pragma("unroll 1") for (int rep_ = 0; rep_ < REP_SWA; ++rep_)
                for (int u = bid; u < 1024; u += G) {
                    A2_CONV();
                    int kvh = u & 3, ch = u >> 2;
                    if (G == 256) { const int b = u & 255, x = b & 7, j = b >> 3; kvh = u >> 8; ch = 32 * x + j; }
                    const int tok0 = ch * 64;
                    const int seqbase = tok0 < 8192 ? (tok0 & ~4095) : (tok0 & ~2047); const int T = tok0 < 8192 ? 4096 : 2048;
                    const int head = kvh * 4 + (wave >> 1);
                    const int tq = tok0 + (wave & 1) * 32 + (lane & 31);
                    int tlo = ch - 2, thi = ch + 3; const int s0 = seqbase >> 6, s1 = (seqbase + T) >> 6; tlo = tlo < s0 ? s0 : tlo; thi = thi > s1 ? s1 : thi;
                    const float sink = kp->in[I_SINKS][head] * LOG2E;
                    attn_unit<128, 2>(lds, SQ + (size_t)tq * 2048 + head * 128, SK + kvh * 128, 512, SVT + (size_t)(kvh * 128) * M, tlo, thi, tlo, thi, tq, 0, sink, lane < 32 ? 1.f : 0.f,
                                      OC + (size_t)tq * 2048 + head * 128);
                }
                if (aunit <= cslot) { aunit = cslot; A2_CONV(); }
#undef A2_CONV
            }
            GRID_SYNC();
            { PHASE_VARS; pg8::EpiResidB Ep{H, nullptr, nullptr, (bf16_t*)X, SS + 1 * M, nullptr}; pg8::run_gemm(lds, (const bf16_t*)(ws + B_OCAT1), (const bf16_t*)(ws + W_ODOUT), D, D, Ep); }
            { PHASE_VARS; pg8::EpiBf16<0> Ep{E, D, nullptr, SS + 4 * M}; pg8::run_gemm(lds, (const bf16_t*)(ws + WS_PB1), (const bf16_t*)(ws + W_PROJ), D, 256, Ep); }
            GRID_SYNC();
    }
    if (PH(9)) { PHASE_VARS; pg8::EpiBf16<1> Ep{(bf16_t*)(ws + B_ACT), DFF, nullptr, nullptr}; pg8::run_gemm(lds, (const bf16_t*)X, (const bf16_t*)(ws + W_UP), DFF, D, Ep); }
    GRID_SYNC();
    if (PH(10)) { PHASE_VARS; pg8::EpiResidB Ep{(const bf16_t*)X, nullptr, nullptr, H, nullptr, SS + 1 * M}; pg8::run_gemm(lds, (const bf16_t*)(ws + B_ACT), (const bf16_t*)(ws + W_DOWN), D, DFF, Ep); }
    GRID_SYNC();
    if (PH(11)) { PHASE_VARS; pg8::EpiGateF32 Ep{H, E, SS + 4 * M, kp->in[I_PLE_NORM] + D, X}; pg8::run_gemm(lds, H, (const bf16_t*)(ws + W_GATE1), D, D, Ep); }
}

extern "C" void kernel_launch(void* const* d_in, const int* in_sizes, int n_in, void* d_out, int out_size, void* d_ws, size_t ws_size, hipStream_t stream) {
    static int grid_blocks = 0;
    if (!grid_blocks) {
        int dev = 0, cus = 0, per_cu = 0;
        hipGetDevice(&dev);
        hipDeviceGetAttribute(&cus, hipDeviceAttributeMultiprocessorCount, dev);
        hipFuncSetAttribute((const void*)fwd_megakernel, hipFuncAttributeMaxDynamicSharedMemorySize, LDS_BYTES);
        hipOccupancyMaxActiveBlocksPerMultiprocessor(&per_cu, (const void*)fwd_megakernel, NTHREADS, LDS_BYTES);
        if (per_cu < 1) per_cu = 1;
        grid_blocks = cus * per_cu;
        if (ws_size < WS_END) fprintf(stderr, "kernel_launch: workspace too small: %zu < %zu\n", ws_size, (size_t)WS_END);
    }
    Params p{};
    for (int i = 0; i < N_IN; ++i) p.in[i] = (const float*)d_in[i];
    p.out = (float*)d_out; p.ws = (unsigned char*)d_ws;
    (void)hipMemsetAsync((char*)d_ws + WS_BAR, 0, XCD_BAR_WORDS * sizeof(unsigned), stream);
    void* args[] = {&p};
    hipError_t e = hipLaunchCooperativeKernel((const void*)fwd_megakernel, dim3(grid_blocks), dim3(NTHREADS), args, LDS_BYTES, stream);
    if (e != hipSuccess) fprintf(stderr, "cooperative launch failed: %s (grid %d)\n", hipGetErrorString(e), grid_blocks);
}
```

```cpp
#include <hip/hip_runtime.h>
#include <hip/hip_cooperative_groups.h>
#include <cstdio>
namespace cg = cooperative_groups;

#define LAS __attribute__((address_space(3)))
typedef unsigned short bf16_t;
typedef short bf16x8 __attribute__((ext_vector_type(8)));
typedef float f32x4 __attribute__((ext_vector_type(4)));
typedef float f32x16 __attribute__((ext_vector_type(16)));
typedef unsigned u32x4 __attribute__((ext_vector_type(4)));
typedef unsigned u32x2 __attribute__((ext_vector_type(2)));

constexpr int M = 16384, D = 2048, DFF = 8192;
constexpr int EV_IN = 3904, EV_INP = 4096, OD_IN = 3072;
constexpr float EPS = 1e-6f;
constexpr float LOG2E = 1.4426950408889634f;
constexpr int NTHREADS = 512, NWAVES = 8;
constexpr int LDS_BYTES = 136 * 1024;
#ifndef ONLY
#define ONLY 0xffffffff
#endif
#define PH(b) (((ONLY) >> (b)) & 1u)
#ifndef REP_CONV
#define REP_CONV 1
#endif
#ifndef REP_ATT
#define REP_ATT 1
#endif
#define REP_MLA 1
#define REP_NA 1
#define REP_SWA 1
#ifndef REP_PREP
#define REP_PREP 1
#endif

enum { I_XP = 0, I_XS, I_PP, I_PS, I_ATTN_NORM, I_MLP_NORM, I_WUP, I_WDOWN, I_PLE_GATE, I_PLE_PROJ, I_PLE_NORM, I_EV_WIN, I_QA_NORM, I_WQB, I_KVA_NORM,
       I_WKVB, I_QNOPE_NORM, I_QROPE_NORM, I_KNOPE_NORM, I_KROPE_NORM, I_NAQ_NORM, I_NAK_NORM, I_RPB, I_EV_WOUT, I_OD_WIN, I_SWAQ_NORM, I_SWAK_NORM, I_SINKS, I_OD_WOUT, N_IN };

struct Params { const float* in[N_IN]; float* out; unsigned char* ws; };
typedef const Params __attribute__((address_space(4)))* KP;
#define KARG(name) KP name = (KP)__builtin_amdgcn_kernarg_segment_ptr(); asm volatile("" : "+s"(name))

constexpr size_t MiB = 1024 * 1024;
constexpr size_t W_UP = 0, W_DOWN = 32 * MiB, W_GATE = 64 * MiB, W_PROJ = 72 * MiB, W_MIX = 73 * MiB;
constexpr size_t W_EVIN = W_MIX, W_QB = W_MIX + 16 * MiB, W_KVB = W_QB + 3 * MiB / 2, W_EVOUT = W_KVB + 1 * MiB;
constexpr size_t W_ODIN = W_MIX, W_ODOUT = W_MIX + 12 * MiB;
constexpr size_t WS_H = 100 * MiB, WS_E = 164 * MiB, WS_PB = 228 * MiB, WS_BIG = 236 * MiB, WS_MISC = 492 * MiB;
constexpr size_t WS_BAR = WS_MISC + 512 * 1024;
constexpr size_t WS_SS = WS_MISC;
constexpr size_t WS_ROPE64 = WS_MISC + 1 * MiB, WS_ROPE128 = WS_MISC + 2 * MiB, W_GATE1 = WS_MISC + 4 * MiB, WS_PB1 = WS_MISC + 12 * MiB, WS_END = WS_MISC + 20 * MiB;
constexpr size_t B_H2 = WS_BIG + 192 * MiB;
constexpr size_t B_Z = WS_BIG;
constexpr size_t B_Q1 = WS_BIG, B_KV1 = WS_BIG + 48 * MiB;
constexpr size_t B_NQ = WS_BIG + 128 * MiB, B_NK = WS_BIG + 160 * MiB, B_NVT = WS_BIG + 192 * MiB;
constexpr size_t B_QN = WS_BIG + 224 * MiB, B_KVN = WS_BIG + 240 * MiB, B_KR = WS_BIG + 248 * MiB;
constexpr size_t B_OCAT0 = WS_BIG;
constexpr size_t HE_QM = WS_H, HE_KM = WS_H + 48 * MiB, HE_VTM = WS_H + 96 * MiB;
constexpr size_t B_SQ = WS_BIG + 96 * MiB, B_SK = WS_BIG + 160 * MiB, B_SVT = WS_BIG + 176 * MiB, B_OCAT1 = WS_BIG + 192 * MiB;
constexpr size_t B_ACT = WS_BIG;

__device__ __forceinline__ unsigned cvt_pk_bf16(float lo, float hi) { unsigned r; asm volatile("v_cvt_pk_bf16_f32 %0, %1, %2" : "=v"(r) : "v"(lo), "v"(hi)); return r; }
__device__ __forceinline__ float bf2f(unsigned short b) { return __uint_as_float(((unsigned)b) << 16); }
__device__ __forceinline__ float bflo(unsigned w) { return __uint_as_float(w << 16); }
__device__ __forceinline__ float bfhi(unsigned w) { return __uint_as_float(w & 0xffff0000u); }
__device__ __forceinline__ unsigned short f2bf(float f) { return (unsigned short)(cvt_pk_bf16(f, 0.f) & 0xffffu); }
__device__ __forceinline__ float wave_sum(float v) {
#pragma unroll
    for (int o = 1; o < 64; o <<= 1) v += __shfl_xor(v, o);
    return v;
}
template <int W> __device__ __forceinline__ float group_sum(float v) {
#pragma unroll
    for (int o = 1; o < W; o <<= 1) v += __shfl_xor(v, o);
    return v;
}
__device__ __forceinline__ int tok_pos(int tok) { return tok < 8192 ? (tok & 4095) : (tok & 2047); }


#define XB_TMO      128
#define XB_XCNT(j)  (256  + 64 * (j))
#define XB_XSUB(j)  (1280 + 64 * (j))
#define XB_XGEN(j)  (2304 + 64 * (j))
#define XB_TOP      3328
#define XB_TOPGEN   3392
#define XCD_BAR_WORDS 3456
#define XB_SPIN_CAP (1u << 18)
__device__ __forceinline__ unsigned xb_ld(unsigned* p)              { return __hip_atomic_load(p, __ATOMIC_RELAXED, __HIP_MEMORY_SCOPE_AGENT); }
__device__ __forceinline__ unsigned xb_add(unsigned* p, unsigned v) { return __hip_atomic_fetch_add(p, v, __ATOMIC_RELAXED, __HIP_MEMORY_SCOPE_AGENT); }
__device__ __forceinline__ unsigned xb_xcc_id() { return (unsigned)__builtin_amdgcn_s_getreg((3 << 11) | 20) & 0xFu; }
#define XB_SPIN(cond, bar) do { unsigned _sp = 0; while (cond) { __builtin_amdgcn_s_sleep(1); \
    if ((++_sp & 255u) == 0u) { if (xb_ld(&(bar)[XB_TMO])) break; if (_sp > XB_SPIN_CAP) { atomicAdd(&(bar)[XB_TMO], 1u); break; } } } } while (0)
struct XcdBarrier { unsigned* bar; unsigned x; volatile LAS unsigned* st; };
__device__ __forceinline__ XcdBarrier xcd_barrier_post(unsigned* bar, volatile LAS unsigned* st) {
    XcdBarrier b; b.bar = bar; b.x = xb_xcc_id(); b.st = st;
    if (threadIdx.x == 0) (void)xb_add(&bar[XB_XCNT(b.x)], 1u);
    return b;
}
__device__ __forceinline__ void xcd_barrier_complete(unsigned* bar, unsigned x, unsigned& nloc, unsigned& nx) {
    const unsigned G = gridDim.x * gridDim.y * gridDim.z;
    unsigned sum, cnt, mine, sp = 0u;
    for (;;) {
        sum = 0u; cnt = 0u; mine = 0u;
#pragma unroll
        for (unsigned j = 0; j < 16; ++j) { const unsigned c = xb_ld(&bar[XB_XCNT(j)]); sum += c; cnt += (c > 0u) ? 1u : 0u; mine = (j == x) ? c : mine; }
        if (sum == G) break;
        __builtin_amdgcn_s_sleep(1);
        if ((++sp & 255u) == 0u) { if (xb_ld(&bar[XB_TMO])) break; if (sp > XB_SPIN_CAP) { atomicAdd(&bar[XB_TMO], 1u); break; } }
    }
    nloc = mine > 0u ? mine : 1u; nx = cnt > 0u ? cnt : 1u;
}
__device__ __forceinline__ void xcd_barrier(const XcdBarrier& b) {
    asm volatile("s_waitcnt vmcnt(0)" ::: "memory");
    __syncthreads();
    if (threadIdx.x == 0) {
        unsigned* bar = b.bar;
        __builtin_amdgcn_s_waitcnt(0);
        unsigned nloc = b.st[0], nx = b.st[1];
        if (nloc == 0u) { xcd_barrier_complete(bar, b.x, nloc, nx); b.st[0] = nloc; b.st[1] = nx; }
        const unsigned old = xb_add(&bar[XB_XSUB(b.x)], 1u);
        const unsigned gen = old / nloc;
        if (old + 1u == (gen + 1u) * nloc) {
            __builtin_amdgcn_fence(__ATOMIC_RELEASE, "agent");
            asm volatile("s_waitcnt vmcnt(0)" ::: "memory");
            const unsigned og = xb_add(&bar[XB_TOP], 1u);
            const unsigned tg = og / nx;
            if (og + 1u == (tg + 1u) * nx) xb_add(&bar[XB_TOPGEN], 1u);
            else XB_SPIN(xb_ld(&bar[XB_TOPGEN]) == tg, bar);
            __builtin_amdgcn_fence(__ATOMIC_ACQUIRE, "agent");
            xb_add(&bar[XB_XGEN(b.x)], 1u);
            asm volatile("s_waitcnt vmcnt(0)" ::: "memory");
        } else {
            XB_SPIN(xb_ld(&bar[XB_XGEN(b.x)]) == gen, bar);
            __builtin_amdgcn_fence(__ATOMIC_ACQUIRE, "agent");
            asm volatile("s_waitcnt vmcnt(0)" ::: "memory");
        }
    }
    __syncthreads();
}

namespace pg8 {
constexpr int BM = 256, BK = 64, HALF = 128, HTB = HALF * BK * 2, STAGE_BYTES = 8 * HTB, NXCD = 8, WGM = 8;
__device__ __forceinline__ int lds_byte(int r, int c) { const int st = (r >> 4) * 2 + (c >> 5), rr = r & 15, cc = c & 31, ob = rr * 64 + cc * 2; return st * 1024 + (ob ^ (((ob >> 9) & 1) << 5)); }
__device__ __forceinline__ void stage_rc(int b, int& R, int& C) { const int st = b / 1024, sb = b % 1024, swz = sb ^ (((sb >> 9) & 1) << 5); R = (st >> 1) * 16 + swz / 64; C = (st & 1) * 32 + (swz % 64) / 2; }
__device__ __forceinline__ int perm32(int rho) { const int n = rho >> 4, i = rho & 15; return 8 * (i >> 2) + 4 * n + (i & 3); }

struct Unit { int pm, pn; };
struct Gemm { const bf16_t* A; const bf16_t* Bt; int M, N, K; };
struct StaticOrder {
    int nM, nN, nwg, G, c, ioff, icnt;
    __device__ void init(int M_, int N_, int G_, int c_, int ioff_ = 0, int icnt_ = 1 << 20) { nM = M_ / BM; nN = N_ / BM; nwg = nM * nN; G = G_; c = c_; ioff = ioff_; icnt = icnt_; }
    __device__ bool next(int i, Unit& u) const {
        if (i >= icnt) return false;
        const long L = (long)(i + ioff) * G + c; if (L >= nwg) return false;
        int wgid = (int)L; { const int q = nwg / NXCD, r = nwg % NXCD, xcd = wgid % NXCD, off = wgid / NXCD; wgid = (xcd < r ? xcd * (q + 1) : r * (q + 1) + (xcd - r) * q) + off; }
        const int nig = WGM * nN, gid = wgid / nig, fm = gid * WGM, gsz = (nM - fm) < WGM ? (nM - fm) : WGM;
        u.pm = fm + ((wgid % nig) % gsz); u.pn = (wgid % nig) / gsz; return true;
    }
};

__device__ __forceinline__ unsigned dpp_ror8(unsigned x) { return (unsigned)__builtin_amdgcn_update_dpp(0, (int)x, 0x128, 0xf, 0xf, false); }
__device__ __forceinline__ void store_pair_lines(bf16_t* O, int ldc, int row, int fr, int col0, u32x4 wA, u32x4 wB) {
    const u32x4 sA = {dpp_ror8(wA.x), dpp_ror8(wA.y), dpp_ror8(wA.z), dpp_ror8(wA.w)}, sB = {dpp_ror8(wB.x), dpp_ror8(wB.y), dpp_ror8(wB.z), dpp_ror8(wB.w)};
    const bool lo = fr < 8;
    const u32x4 o1 = lo ? wA : sB, o2 = lo ? sA : wB;
    const int r1 = row - fr + (fr & 7), cb = col0 + (lo ? 0 : 8);
    *(u32x4*)(O + (size_t)r1 * ldc + cb) = o1;
    *(u32x4*)(O + (size_t)(r1 + 8) * ldc + cb) = o2;
}
__device__ __forceinline__ void load_pair_lines(const bf16_t* P, int ld, int row, int fr, int col0, u32x4& wA, u32x4& wB, int boff = 8) {
    const bool lo = fr < 8;
    const int r1 = row - fr + (fr & 7), cb = col0 + (lo ? 0 : boff);
    const u32x4 l1 = *(const u32x4*)(P + (size_t)r1 * ld + cb), l2 = *(const u32x4*)(P + (size_t)(r1 + 8) * ld + cb);
    const u32x4 s1 = {dpp_ror8(l1.x), dpp_ror8(l1.y), dpp_ror8(l1.z), dpp_ror8(l1.w)}, s2 = {dpp_ror8(l2.x), dpp_ror8(l2.y), dpp_ror8(l2.z), dpp_ror8(l2.w)};
    wA = lo ? l1 : s2; wB = lo ? s1 : l2;
}
template <int ACT  > struct EpiBf16 {
    static constexpr bool PERM = true, F32OUT = false;
    bf16_t* O; int ldc;
    const float* ssin;
    float* ssout;
    __device__ __forceinline__ void operator()(const f32x4 (&acc)[2][2][4][2], const Unit& u, int wr, int wc, int fr, int fq) const {
        const int row0 = u.pm * BM + wr * 64 + fr; const int col0 = u.pn * BM + wc * 64 + 16 * fq;
#pragma unroll
        for (int ai = 0; ai < 2; ++ai)
#pragma unroll
            for (int m = 0; m < 4; ++m) { const int row = row0 + ai * HALF + m * 16;
                const float rs = ssin ? __builtin_amdgcn_rsqf(ssin[row] * (1.f / D) + EPS) : 1.0f; float sq = 0.f; u32x4 w[2];
#pragma unroll
                for (int bj = 0; bj < 2; ++bj) { f32x4 v0 = acc[ai][bj][m][0] * rs, v1 = acc[ai][bj][m][1] * rs;
                    if (ACT == 1) {
#pragma unroll
                        for (int j = 0; j < 4; ++j) { const float a = fmaxf(v0[j], 0.f), b = fmaxf(v1[j], 0.f); v0[j] = a * a; v1[j] = b * b; } }
                    sq += (v0[0] * v0[0] + v0[1] * v0[1]) + (v0[2] * v0[2] + v0[3] * v0[3]) + (v1[0] * v1[0] + v1[1] * v1[1]) + (v1[2] * v1[2] + v1[3] * v1[3]);
                    w[bj].x = cvt_pk_bf16(v0[0], v0[1]); w[bj].y = cvt_pk_bf16(v0[2], v0[3]); w[bj].z = cvt_pk_bf16(v1[0], v1[1]); w[bj].w = cvt_pk_bf16(v1[2], v1[3]); }
                store_pair_lines(O, ldc, row, fr, col0, w[0], w[1]);
                if (ssout) { sq += __shfl_xor(sq, 16); sq += __shfl_xor(sq, 32); if (fq == 0) unsafeAtomicAdd(ssout + row, sq); } }
    }
};
struct EpiResid {
    static constexpr bool PERM = false, F32OUT = false;
    float* X; bf16_t* XB; float* ssout;
    const float* rsin;
    const float* src_p; const float* src_s;
    __device__ __forceinline__ void operator()(const f32x4 (&acc)[2][2][4][2], const Unit& u, int wr, int wc, int fr, int fq) const {
        const int row0 = u.pm * BM + wr * 64 + fr, col0 = u.pn * BM + wc * 32 + 4 * fq;
#pragma unroll
        for (int ai = 0; ai < 2; ++ai)
#pragma unroll
            for (int m = 0; m < 4; ++m) { const int row = row0 + ai * HALF + m * 16; const size_t off = (size_t)row * D + col0; float sq = 0.f;
                const float sc = rsin ? __builtin_amdgcn_rcpf(rsin[row] * (1.f / D) + EPS) : 1.0f;
                const float* rp = src_p ? (row < 8192 ? src_p + off : src_s + (off - (size_t)8192 * D)) : X + off;
#pragma unroll
                for (int bj = 0; bj < 2; ++bj)
#pragma unroll
                    for (int n = 0; n < 2; ++n) { const f32x4 o = *(const f32x4*)(rp + bj * HALF + n * 16) + acc[ai][bj][m][n] * sc; *(f32x4*)(X + off + bj * HALF + n * 16) = o;
                        sq += (o[0] * o[0] + o[1] * o[1]) + (o[2] * o[2] + o[3] * o[3]);
                        u32x2 w; w.x = cvt_pk_bf16(o[0], o[1]); w.y = cvt_pk_bf16(o[2], o[3]); *(u32x2*)(XB + off + bj * HALF + n * 16) = w; }
                if (ssout) { sq += __shfl_xor(sq, 16); sq += __shfl_xor(sq, 32); if (fq == 0) unsafeAtomicAdd(ssout + row, sq); } }
    }
};
struct EpiGate {
    static constexpr bool PERM = false, F32OUT = false;
    float* X; const bf16_t* E; const float* sse; const float* g; bf16_t* XB; float* ssout;
    __device__ __forceinline__ void operator()(const f32x4 (&acc)[2][2][4][2], const Unit& u, int wr, int wc, int fr, int fq) const {
        const int row0 = u.pm * BM + wr * 64 + fr, col0 = u.pn * BM + wc * 32 + 4 * fq;
        f32x4 gv[2][2];
#pragma unroll
        for (int bj = 0; bj < 2; ++bj)
#pragma unroll
            for (int n = 0; n < 2; ++n) gv[bj][n] = *(const f32x4*)(g + col0 + bj * HALF + n * 16);
#pragma unroll
        for (int ai = 0; ai < 2; ++ai)
#pragma unroll
            for (int m = 0; m < 4; ++m) { const int row = row0 + ai * HALF + m * 16; const size_t off = (size_t)row * D + col0; const float ri = __builtin_amdgcn_rsqf(sse[row] * (1.f / D) + EPS); float sq = 0.f;
#pragma unroll
                for (int bj = 0; bj < 2; ++bj)
#pragma unroll
                    for (int n = 0; n < 2; ++n) { float* p = X + off + bj * HALF + n * 16; const u32x2 ew = *(const u32x2*)(E + off + bj * HALF + n * 16);
                        const f32x4 a = acc[ai][bj][m][n]; const f32x4 gg = gv[bj][n]; f32x4 o = *(const f32x4*)p;
                        const float e0 = bflo(ew.x), e1 = bfhi(ew.x), e2 = bflo(ew.y), e3 = bfhi(ew.y);
                        o[0] += e0 * ri * gg[0] * __builtin_amdgcn_rcpf(1.f + __builtin_amdgcn_exp2f(-a[0] * LOG2E));
                        o[1] += e1 * ri * gg[1] * __builtin_amdgcn_rcpf(1.f + __builtin_amdgcn_exp2f(-a[1] * LOG2E));
                        o[2] += e2 * ri * gg[2] * __builtin_amdgcn_rcpf(1.f + __builtin_amdgcn_exp2f(-a[2] * LOG2E));
                        o[3] += e3 * ri * gg[3] * __builtin_amdgcn_rcpf(1.f + __builtin_amdgcn_exp2f(-a[3] * LOG2E));
                        *(f32x4*)p = o;
                        if (XB) { sq += (o[0] * o[0] + o[1] * o[1]) + (o[2] * o[2] + o[3] * o[3]);
                            u32x2 w; w.x = cvt_pk_bf16(o[0], o[1]); w.y = cvt_pk_bf16(o[2], o[3]); *(u32x2*)(XB + off + bj * HALF + n * 16) = w; } }
                if (XB) { sq += __shfl_xor(sq, 16); sq += __shfl_xor(sq, 32); if (fq == 0) unsafeAtomicAdd(ssout + row, sq); } }
    }
};

struct EpiResidB {
    static constexpr bool PERM = true, F32OUT = false;
    const bf16_t* R;
    const float* src_p; const float* src_s;
    bf16_t* O;
    float* ssout;
    const float* rsin;
    __device__ __forceinline__ void operator()(const f32x4 (&acc)[2][2][4][2], const Unit& u, int wr, int wc, int fr, int fq) const {
        const int row0 = u.pm * BM + wr * 64 + fr, col0 = u.pn * BM + wc * 64 + 16 * fq;
#pragma unroll
        for (int ai = 0; ai < 2; ++ai)
#pragma unroll
            for (int m = 0; m < 4; ++m) { const int row = row0 + ai * HALF + m * 16; const size_t off = (size_t)row * D + col0; float sq = 0.f; u32x4 w[2];
                const float sc = rsin ? __builtin_amdgcn_rcpf(rsin[row] * (1.f / D) + EPS) : 1.0f;
                u32x4 rr[2]; if (R) load_pair_lines(R, D, row, fr, col0, rr[0], rr[1]);
#pragma unroll
                for (int bj = 0; bj < 2; ++bj) { f32x4 r0, r1;
                    if (R) { const u32x4 rw = rr[bj]; r0 = (f32x4){bflo(rw.x), bfhi(rw.x), bflo(rw.y), bfhi(rw.y)}; r1 = (f32x4){bflo(rw.z), bfhi(rw.z), bflo(rw.w), bfhi(rw.w)}; }
                    else { const float* rp = (row < 8192 ? src_p + off : src_s + (off - (size_t)8192 * D)) + 8 * bj; r0 = *(const f32x4*)rp; r1 = *(const f32x4*)(rp + 4); }
                    const f32x4 o0 = r0 + acc[ai][bj][m][0] * sc, o1 = r1 + acc[ai][bj][m][1] * sc;
                    sq += (o0[0] * o0[0] + o0[1] * o0[1]) + (o0[2] * o0[2] + o0[3] * o0[3]) + (o1[0] * o1[0] + o1[1] * o1[1]) + (o1[2] * o1[2] + o1[3] * o1[3]);
                    w[bj].x = cvt_pk_bf16(o0[0], o0[1]); w[bj].y = cvt_pk_bf16(o0[2], o0[3]); w[bj].z = cvt_pk_bf16(o1[0], o1[1]); w[bj].w = cvt_pk_bf16(o1[2], o1[3]); }
                store_pair_lines(O, D, row, fr, col0, w[0], w[1]);
                if (ssout) { sq += __shfl_xor(sq, 16); sq += __shfl_xor(sq, 32); if (fq == 0) unsafeAtomicAdd(ssout + row, sq); } }
    }
};
struct EpiGateB {
    static constexpr bool PERM = true, F32OUT = false;
    const bf16_t* R; const bf16_t* E; const float* sse; const float* g; bf16_t* O; float* ssout; float* OUT;
    __device__ __forceinline__ void operator()(const f32x4 (&acc)[2][2][4][2], const Unit& u, int wr, int wc, int fr, int fq) const {
        const int row0 = u.pm * BM + wr * 64 + fr, col0 = u.pn * BM + wc * 64 + 16 * fq;
        f32x4 gv[2][2];
#pragma unroll
        for (int bj = 0; bj < 2; ++bj) { gv[bj][0] = *(const f32x4*)(g + col0 + 8 * bj); gv[bj][1] = *(const f32x4*)(g + col0 + 8 * bj + 4); }
#pragma unroll
        for (int ai = 0; ai < 2; ++ai)
#pragma unroll
            for (int m = 0; m < 4; ++m) { const int row = row0 + ai * HALF + m * 16; const size_t off = (size_t)row * D + col0; const float ri = __builtin_amdgcn_rsqf(sse[row] * (1.f / D) + EPS); float sq = 0.f; u32x4 w[2];
                u32x4 rr[2], ee[2]; load_pair_lines(R, D, row, fr, col0, rr[0], rr[1]); load_pair_lines(E, D, row, fr, col0, ee[0], ee[1]);
#pragma unroll
                for (int bj = 0; bj < 2; ++bj) { const u32x4 rw = rr[bj], ew = ee[bj];
                    const float r[8] = {bflo(rw.x), bfhi(rw.x), bflo(rw.y), bfhi(rw.y), bflo(rw.z), bfhi(rw.z), bflo(rw.w), bfhi(rw.w)};
                    const float e[8] = {bflo(ew.x), bfhi(ew.x), bflo(ew.y), bfhi(ew.y), bflo(ew.z), bfhi(ew.z), bflo(ew.w), bfhi(ew.w)};
                    float o[8];
#pragma unroll
                    for (int j = 0; j < 8; ++j) { const float a = acc[ai][bj][m][j >> 2][j & 3]; const float gg = gv[bj][j >> 2][j & 3];
                        o[j] = r[j] + e[j] * ri * gg * __builtin_amdgcn_rcpf(1.f + __builtin_amdgcn_exp2f(-a * LOG2E)); }
                    if (OUT) { *(f32x4*)(OUT + off + 8 * bj) = (f32x4){o[0], o[1], o[2], o[3]}; *(f32x4*)(OUT + off + 8 * bj + 4) = (f32x4){o[4], o[5], o[6], o[7]}; }
                    else { sq += (o[0] * o[0] + o[1] * o[1]) + (o[2] * o[2] + o[3] * o[3]) + (o[4] * o[4] + o[5] * o[5]) + (o[6] * o[6] + o[7] * o[7]);
                        w[bj].x = cvt_pk_bf16(o[0], o[1]); w[bj].y = cvt_pk_bf16(o[2], o[3]); w[bj].z = cvt_pk_bf16(o[4], o[5]); w[bj].w = cvt_pk_bf16(o[6], o[7]); } }
                if (!OUT) { store_pair_lines(O, D, row, fr, col0, w[0], w[1]);
                    sq += __shfl_xor(sq, 16); sq += __shfl_xor(sq, 32); if (fq == 0) unsafeAtomicAdd(ssout + row, sq); } }
    }
};

struct EpiGateF32 {
    static constexpr bool PERM = true, F32OUT = true;
    const bf16_t* R; const bf16_t* E; const float* sse; const float* g; float* OUT;
    __device__ __forceinline__ void operator()(const f32x4 (&acc)[2][2][4][2], const Unit& u, int wr, int wc, int fr, int fq) const {
        const int row0 = u.pm * BM + wr * 64 + fr, col0 = u.pn * BM + wc * 64 + 8 * fq;
        f32x4 gv[2][2];
#pragma unroll
        for (int bj = 0; bj < 2; ++bj) { gv[bj][0] = *(const f32x4*)(g + col0 + 32 * bj); gv[bj][1] = *(const f32x4*)(g + col0 + 32 * bj + 4); }
        const bool lo = fr < 8;
#pragma unroll
        for (int ai = 0; ai < 2; ++ai)
#pragma unroll
            for (int m = 0; m < 4; ++m) { const int row = row0 + ai * HALF + m * 16; const float ri = __builtin_amdgcn_rsqf(sse[row] * (1.f / D) + EPS);
                u32x4 rr[2], ee[2]; load_pair_lines(R, D, row, fr, col0, rr[0], rr[1], 32); load_pair_lines(E, D, row, fr, col0, ee[0], ee[1], 32);
                float* orow = OUT + (size_t)(row - fr + (fr & 7)) * D + col0 + (lo ? 0 : 4);
#pragma unroll
                for (int bj = 0; bj < 2; ++bj) { const u32x4 rw = rr[bj], ew = ee[bj];
                    const float r[8] = {bflo(rw.x), bfhi(rw.x), bflo(rw.y), bfhi(rw.y), bflo(rw.z), bfhi(rw.z), bflo(rw.w), bfhi(rw.w)};
                    const float e[8] = {bflo(ew.x), bfhi(ew.x), bflo(ew.y), bfhi(ew.y), bflo(ew.z), bfhi(ew.z), bflo(ew.w), bfhi(ew.w)};
                    float o[8];
#pragma unroll
                    for (int j = 0; j < 8; ++j) { const float a = acc[ai][bj][m][j >> 2][j & 3]; const float gg = gv[bj][j >> 2][j & 3];
                        o[j] = r[j] + e[j] * ri * gg * __builtin_amdgcn_rcpf(1.f + __builtin_amdgcn_exp2f(-a * LOG2E)); }
                    f32x4 o1, o2;
#pragma unroll
                    for (int j = 0; j < 4; ++j) { const unsigned a = __float_as_uint(o[j]), b = __float_as_uint(o[4 + j]); const unsigned sa = dpp_ror8(a), sb = dpp_ror8(b);
                        o1[j] = __uint_as_float(lo ? a : sb); o2[j] = __uint_as_float(lo ? sa : b); }
                    *(f32x4*)(orow + 32 * bj) = o1; *(f32x4*)(orow + (size_t)8 * D + 32 * bj) = o2; } }
    }
};

template <class Epi>
__device__ __forceinline__ void gemm_phase(LAS unsigned char* lds, const Gemm g, const StaticOrder& S, const Epi& E) {
    int tid = threadIdx.x; asm volatile("" : "+v"(tid));
    const int wid = __builtin_amdgcn_readfirstlane(tid >> 6), lane = tid & 63, wr = wid >> 2, wc = wid & 3, fr = lane & 15, fq = lane >> 4;
    const int K = g.K, nt = K / BK;
    unsigned voffA[2], voffB0[2], voffB1[2];
#pragma unroll
    for (int i = 0; i < 2; ++i) { int R, C; stage_rc(tid * 16 + i * 8192, R, C);
        const int Rw = 64 * (R >> 5) + 16 * ((R >> 2) & 3) + 4 * ((R >> 4) & 1) + (R & 3);
        const int Rf = 64 * (R >> 5) + 8 * ((R >> 2) & 3) + 4 * ((R >> 4) & 1) + (R & 3);
        const int Rb0 = Epi::PERM ? (Epi::F32OUT ? Rf : Rw) : R, Rb1 = Epi::PERM ? (Epi::F32OUT ? Rf + 32 : Rw + 8) : R + HALF;
        voffA[i] = (unsigned)(R * K + C) * 2u; voffB0[i] = (unsigned)(Rb0 * K + C) * 2u; voffB1[i] = (unsigned)(Rb1 * K + C) * 2u; }
    const size_t kstep = (size_t)(BK * 2);
    const size_t hstep = (size_t)HALF * K * 2;
    const size_t tstep = 2 * hstep;
    const unsigned ldsw = (unsigned)wid * 1024u;
    const int aoff = lds_byte(wr * 64 + fr, fq * 8), boff = lds_byte(wc * 32 + fr, fq * 8);
#define PG8_SA(b, h) (((b) * 2 + (h)) * HTB)
#define PG8_SB(b, h) ((4 + (b) * 2 + (h)) * HTB)
#define PG8_STAGE(bufoff, gbase, voff) do { _Pragma("unroll") for (int _i = 0; _i < 2; ++_i) \
        __builtin_amdgcn_global_load_lds((const unsigned*)((const char*)(gbase) + (voff)[_i]), (LAS unsigned*)(lds + (bufoff) + ldsw + _i * 8192), 16, 0, 0); } while (0)
#define PG8_LDA(dst, b, h) do { _Pragma("unroll") for (int m = 0; m < 4; ++m) _Pragma("unroll") for (int k = 0; k < 2; ++k) dst[m][k] = *(const LAS bf16x8*)(lds + PG8_SA(b, h) + aoff + m * 2048 + k * 1024); } while (0)
#define PG8_LDB(dst, b, h) do { _Pragma("unroll") for (int n = 0; n < 2; ++n) _Pragma("unroll") for (int k = 0; k < 2; ++k) dst[n][k] = *(const LAS bf16x8*)(lds + PG8_SB(b, h) + boff + n * 2048 + k * 1024); } while (0)
#define PG8_MMA(ai, bj, At, Bt) do { __builtin_amdgcn_s_setprio(1); _Pragma("unroll") for (int m = 0; m < 4; ++m) _Pragma("unroll") for (int n = 0; n < 2; ++n) _Pragma("unroll") for (int k = 0; k < 2; ++k) \
        acc[ai][bj][m][n] = __builtin_amdgcn_mfma_f32_16x16x32_bf16(Bt[n][k], At[m][k], acc[ai][bj][m][n], 0, 0, 0); __builtin_amdgcn_s_setprio(0); } while (0)
#define PG8_WAIT_V(n) asm volatile("s_waitcnt vmcnt(" #n ")" ::: "memory")
#define PG8_WAIT_L(n) asm volatile("s_waitcnt lgkmcnt(" #n ")" ::: "memory")
#define PG8_BAR __builtin_amdgcn_s_barrier()
#define PG8_SCHED __builtin_amdgcn_sched_barrier(0)
    Unit cur, nxt; int ui = 0;
    if (!S.next(0, cur)) return;
    f32x4 acc[2][2][4][2];
#pragma unroll
    for (int a = 0; a < 2; ++a)
#pragma unroll
        for (int b = 0; b < 2; ++b)
#pragma unroll
            for (int m = 0; m < 4; ++m)
#pragma unroll
                for (int n = 0; n < 2; ++n) acc[a][b][m][n] = (f32x4){0.f, 0.f, 0.f, 0.f};
    bf16x8 At[4][2], B0[2][2], B1[2][2];
    const char* cA = (const char*)g.A + (size_t)cur.pm * tstep; const char* cB = (const char*)g.Bt + (size_t)cur.pn * tstep;
    PG8_STAGE(PG8_SB(0, 0), cB, voffB0); PG8_STAGE(PG8_SA(0, 0), cA, voffA); PG8_STAGE(PG8_SB(0, 1), cB, voffB1); PG8_STAGE(PG8_SA(0, 1), cA + hstep, voffA);
    if (wr == 1) PG8_BAR;
    PG8_WAIT_V(4); PG8_BAR;
    PG8_STAGE(PG8_SB(1, 0), cB + kstep, voffB0); PG8_STAGE(PG8_SA(1, 0), cA + kstep, voffA); PG8_STAGE(PG8_SB(1, 1), cB + kstep, voffB1);
    PG8_WAIT_V(6); PG8_BAR;
    for (;;) {
        const bool has_next = S.next(ui + 1, nxt);
        const char* nA = has_next ? (const char*)g.A + (size_t)nxt.pm * tstep : cA; const char* nB = has_next ? (const char*)g.Bt + (size_t)nxt.pn * tstep : cB;
        for (int t = 0; t < nt; t += 2) {
            const bool last = (t == nt - 2);
            const char* a1 = cA + (size_t)(t + 1) * kstep;
            const char* a2 = last ? nA : cA + (size_t)(t + 2) * kstep; const char* b2 = last ? nB : cB + (size_t)(t + 2) * kstep;
            const char* a3 = a2 + kstep; const char* b3 = b2 + kstep;
            PG8_LDB(B0, 0, 0); PG8_SCHED; PG8_LDA(At, 0, 0); PG8_STAGE(PG8_SA(1, 1), a1 + hstep, voffA);
            PG8_WAIT_L(8); PG8_BAR; PG8_WAIT_L(0); PG8_MMA(0, 0, At, B0); PG8_BAR; PG8_SCHED;
            PG8_LDB(B1, 0, 1); PG8_STAGE(PG8_SB(0, 0), b2, voffB0);
            PG8_BAR; PG8_WAIT_L(0); PG8_MMA(0, 1, At, B1); PG8_BAR;
            PG8_LDA(At, 0, 1); PG8_STAGE(PG8_SA(0, 0), a2, voffA);
            PG8_BAR; PG8_WAIT_L(0); PG8_MMA(1, 0, At, B0); PG8_BAR; PG8_SCHED;
            PG8_STAGE(PG8_SB(0, 1), b2, voffB1);
            PG8_WAIT_V(6); PG8_BAR; PG8_MMA(1, 1, At, B1); PG8_BAR;
            PG8_LDB(B0, 1, 0); PG8_SCHED; PG8_LDA(At, 1, 0); PG8_STAGE(PG8_SA(0, 1), a2 + hstep, voffA);
            PG8_WAIT_L(8); PG8_BAR; PG8_WAIT_L(0); PG8_MMA(0, 0, At, B0); PG8_BAR; PG8_SCHED;
            PG8_LDB(B1, 1, 1); PG8_STAGE(PG8_SB(1, 0), b3, voffB0);
            PG8_BAR; PG8_WAIT_L(0); PG8_MMA(0, 1, At, B1); PG8_BAR;
            PG8_LDA(At, 1, 1); PG8_STAGE(PG8_SA(1, 0), a3, voffA);
            PG8_BAR; PG8_WAIT_L(0); PG8_MMA(1, 0, At, B0); PG8_BAR; PG8_SCHED;
            PG8_STAGE(PG8_SB(1, 1), b3, voffB1);
            PG8_WAIT_V(6); PG8_BAR; PG8_MMA(1, 1, At, B1); PG8_BAR;
        }
        E(acc, cur, wr, wc, fr, fq);
        if (!has_next) break;
#pragma unroll
        for (int a = 0; a < 2; ++a)
#pragma unroll
            for (int b = 0; b < 2; ++b)
#pragma unroll
                for (int m = 0; m < 4; ++m)
#pragma unroll
                    for (int n = 0; n < 2; ++n) acc[a][b][m][n] = (f32x4){0.f, 0.f, 0.f, 0.f};
        cur = nxt; cA = nA; cB = nB; ++ui;
    }
    PG8_WAIT_V(0);
    if (wr == 0) PG8_BAR;
    PG8_BAR;
#undef PG8_SA
#undef PG8_SB
#undef PG8_STAGE
#undef PG8_LDA
#undef PG8_LDB
#undef PG8_MMA
#undef PG8_WAIT_V
#undef PG8_WAIT_L
#undef PG8_BAR
#undef PG8_SCHED
}
template <class Epi>
__device__ __forceinline__ void run_gemm(LAS unsigned char* lds, const bf16_t* A, const bf16_t* Bt, int N, int K, const Epi& E, int ioff = 0, int icnt = 1 << 20) {
    Gemm g{A, Bt, M, N, K}; StaticOrder S; S.init(M, N, (int)gridDim.x, (int)blockIdx.x, ioff, icnt);
    gemm_phase<Epi>(lds, g, S, E);
    __syncthreads();
}
}

__device__ __forceinline__ void transpose_item(const float* W, int K, int N, bf16_t* WT, LAS float* scr, int item, int lane, const float* gk) {
    const int nblk = N / 64, kb = item / nblk, nb = item % nblk, k0 = 64 * kb, n0 = 64 * nb;
    f32x4 v[16];
#pragma unroll
    for (int i = 0; i < 16; ++i) { const int kk = 4 * i + (lane >> 4); v[i] = *(const f32x4*)(W + (size_t)(k0 + kk) * N + n0 + 4 * (lane & 15)); }
    if (gk) {
#pragma unroll
        for (int i = 0; i < 16; ++i) v[i] *= gk[k0 + 4 * i + (lane >> 4)]; }
#pragma unroll
    for (int i = 0; i < 16; ++i) { LAS float* d = scr + (4 * i + (lane >> 4)) * 65 + 4 * (lane & 15); d[0] = v[i][0]; d[1] = v[i][1]; d[2] = v[i][2]; d[3] = v[i][3]; }
    asm volatile("s_waitcnt lgkmcnt(0)" ::: "memory");
    const int c = lane & 7;
#pragma unroll
    for (int j = 0; j < 8; ++j) { const int n = (lane >> 3) + 8 * j; const LAS float* s = scr + (8 * c) * 65 + n;
        u32x4 o; o.x = cvt_pk_bf16(s[0 * 65], s[1 * 65]); o.y = cvt_pk_bf16(s[2 * 65], s[3 * 65]); o.z = cvt_pk_bf16(s[4 * 65], s[5 * 65]); o.w = cvt_pk_bf16(s[6 * 65], s[7 * 65]);
        *(u32x4*)(WT + (size_t)(n0 + n) * K + k0 + 8 * c) = o; }
    asm volatile("s_waitcnt lgkmcnt(0)" ::: "memory");
}
__device__ __forceinline__ void convert_matrix(const float* W, int K, int N, bf16_t* WT, LAS float* scr, int gw, int ngw, int lane, const float* gk = nullptr) {
    const int nitems = (K / 64) * (N / 64);
    for (int it = gw; it < nitems; it += ngw) transpose_item(W, K, N, WT, scr, it, lane, gk);
}

__device__ __forceinline__ void norm_row(const float* xrow, const float* g, bf16_t* orow, float* xcopy, int lane) {
    f32x4 v[8]; float s = 0.f;
#pragma unroll
    for (int j = 0; j < 4; ++j) { v[2 * j] = ((const f32x4*)xrow)[2 * (lane + 64 * j)]; v[2 * j + 1] = ((const f32x4*)xrow)[2 * (lane + 64 * j) + 1]; }
#pragma unroll
    for (int j = 0; j < 8; ++j) s += (v[j][0] * v[j][0] + v[j][1] * v[j][1]) + (v[j][2] * v[j][2] + v[j][3] * v[j][3]);
    if (xcopy) {
#pragma unroll
        for (int j = 0; j < 4; ++j) { ((f32x4*)xcopy)[2 * (lane + 64 * j)] = v[2 * j]; ((f32x4*)xcopy)[2 * (lane + 64 * j) + 1] = v[2 * j + 1]; } }
    const float rinv = 1.0f / sqrtf(wave_sum(s) * (1.f / D) + EPS);
#pragma unroll
    for (int j = 0; j < 4; ++j) { const f32x4 g0 = ((const f32x4*)g)[2 * (lane + 64 * j)], g1 = ((const f32x4*)g)[2 * (lane + 64 * j) + 1]; const f32x4 a = v[2 * j], c = v[2 * j + 1];
        u32x4 w; w.x = cvt_pk_bf16(a[0] * rinv * g0[0], a[1] * rinv * g0[1]); w.y = cvt_pk_bf16(a[2] * rinv * g0[2], a[3] * rinv * g0[3]);
        w.z = cvt_pk_bf16(c[0] * rinv * g1[0], c[1] * rinv * g1[1]); w.w = cvt_pk_bf16(c[2] * rinv * g1[2], c[3] * rinv * g1[3]);
        ((u32x4*)orow)[lane + 64 * j] = w; }
}
__device__ __forceinline__ float rinv_row_bf16(const bf16_t* erow, int lane) {
    float s = 0.f;
#pragma unroll
    for (int j = 0; j < 4; ++j) { const u32x4 w = ((const u32x4*)erow)[lane + 64 * j];
        const float a0 = bflo(w.x), a1 = bfhi(w.x), a2 = bflo(w.y), a3 = bfhi(w.y), a4 = bflo(w.z), a5 = bfhi(w.z), a6 = bflo(w.w), a7 = bfhi(w.w);
        s += (a0 * a0 + a1 * a1) + (a2 * a2 + a3 * a3) + (a4 * a4 + a5 * a5) + (a6 * a6 + a7 * a7); }
    return 1.0f / sqrtf(wave_sum(s) * (1.f / D) + EPS);
}
__device__ __forceinline__ void conv_p_row(const float* prow, bf16_t* orow, int lane) {
    const f32x4 v = ((const f32x4*)prow)[lane]; u32x2 w; w.x = cvt_pk_bf16(v[0], v[1]); w.y = cvt_pk_bf16(v[2], v[3]); ((u32x2*)orow)[lane] = w;
}

template <int LIST>
__device__ __forceinline__ void convert_list(KP kp, unsigned char* ws, LAS float* scr, int gw, int ngw, int lane) {
#pragma unroll 1
    for (int m = 0; m < (LIST == 0 ? 6 : 5); ++m) {
        const float* W; int K, N; size_t dst; const float* gk = nullptr;
        if (LIST == 0) {
            switch (m) {
                case 0:  W = kp->in[I_WUP]; K = D; N = DFF; dst = W_UP; gk = kp->in[I_MLP_NORM]; break;
                case 1:  W = kp->in[I_WDOWN]; K = DFF; N = D; dst = W_DOWN; break;
                case 2:  W = kp->in[I_PLE_GATE]; K = D; N = D; dst = W_GATE; break;
                case 3:  W = kp->in[I_EV_WOUT]; K = D; N = D; dst = W_EVOUT; break;
                case 4:  W = kp->in[I_PLE_PROJ]; K = 256; N = D; dst = W_PROJ; break;
                default: W = kp->in[I_OD_WIN]; K = D; N = OD_IN; dst = W_ODIN; gk = kp->in[I_ATTN_NORM] + D; break;
            }
        } else {
            switch (m) {
                case 0:  W = kp->in[I_OD_WOUT]; K = D; N = D; dst = W_ODOUT; break;
                case 1:  W = kp->in[I_WUP] + (size_t)D * DFF; K = D; N = DFF; dst = W_UP; gk = kp->in[I_MLP_NORM] + D; break;
                case 2:  W = kp->in[I_WDOWN] + (size_t)D * DFF; K = DFF; N = D; dst = W_DOWN; break;
                case 3:  W = kp->in[I_PLE_GATE] + (size_t)D * D; K = D; N = D; dst = W_GATE1; break;
                default: W = kp->in[I_PLE_PROJ] + (size_t)256 * D; K = 256; N = D; dst = W_PROJ; break;
            }
        }
        convert_matrix(W, K, N, (bf16_t*)(ws + dst), scr, gw, ngw, lane, gk);
    }
    bf16_t* PBo = (bf16_t*)(ws + (LIST == 0 ? WS_PB : WS_PB1));
    for (int row = gw; row < M; row += ngw) {
        const float* pr = (row < 8192 ? kp->in[I_PP] + (size_t)row * 256 : kp->in[I_PS] + (size_t)(row - 8192) * 256) + (LIST == 0 ? (size_t)0 : (size_t)8192 * 256);
        conv_p_row(pr, PBo + (size_t)row * 256, lane);
    }
}

__device__ __forceinline__ void vt_item(LAS unsigned char* lds, const bf16_t* src, int sstride, bf16_t* vt_rows, int tok0) {
    int tid = threadIdx.x; asm volatile("" : "+v"(tid));
    constexpr int TROW = 272;
#pragma unroll
    for (int i = 0; i < 2; ++i) { const int cid = tid + i * 512, row = cid >> 4, cc = cid & 15;
        const u32x4 v = *(const u32x4*)(src + (size_t)row * sstride + cc * 8);
        *(LAS u32x4*)(lds + row * TROW + cc * 16) = v; }
    __syncthreads();
#pragma unroll
    for (int i = 0; i < 2; ++i) { const int wid2 = tid + i * 512, d = wid2 >> 3, ck = wid2 & 7;
        unsigned short e[8];
#pragma unroll
        for (int j = 0; j < 8; ++j) { const int quad = (ck & 1) * 2 + (j >> 2); const int q2 = (quad == 1) ? 2 : (quad == 2 ? 1 : quad); const int t = (ck >> 1) * 16 + q2 * 4 + (j & 3);
            e[j] = *(const LAS unsigned short*)(lds + t * TROW + d * 2); }
        u32x4 o; o.x = e[0] | ((unsigned)e[1] << 16); o.y = e[2] | ((unsigned)e[3] << 16); o.z = e[4] | ((unsigned)e[5] << 16); o.w = e[6] | ((unsigned)e[7] << 16);
        *(u32x4*)(vt_rows + (size_t)d * M + tok0 + ck * 8) = o; }
    __syncthreads();
}

__device__ __forceinline__ int crow(int r, int hi) { return (r & 3) + 8 * (r >> 2) + 4 * hi; }
template <int DQK> struct AG { static constexpr int KROW = DQK * 2 + 16, KBUF = 64 * KROW, VROW = 144, VBUF = 128 * VROW, VOFF = 2 * KBUF, KC = (64 * DQK / 8) / 512, RPB_OFF = 2 * KBUF + 3 * VBUF; };

template <int DQK, int MODE>
__device__ __forceinline__ void attn_unit(LAS unsigned char* lds, const bf16_t* qptr, const bf16_t* kbase, int kstride, const bf16_t* vtbase,
                                          int tile_lo, int tile_hi, int wlo, int whi, int a0  , int a1  ,
                                          float m_init, float l_init, bf16_t* optr) {
    typedef AG<DQK> G;
    int tid = threadIdx.x; asm volatile("" : "+v"(tid));
    const int lane = tid & 63, r32 = lane & 31, hh = lane >> 5;
    bf16x8 qf[DQK / 16];
#pragma unroll
    for (int dc = 0; dc < DQK / 16; ++dc) qf[dc] = *(const bf16x8*)(qptr + dc * 16 + hh * 8);
    f32x16 O[4];
#pragma unroll
    for (int i = 0; i < 4; ++i)
#pragma unroll
        for (int j = 0; j < 16; ++j) O[i][j] = 0.f;
    float m = m_init, l = l_init;
    const int nt = tile_hi - tile_lo;
    u32x4 kreg[G::KC], vreg[2];
    int krow_[G::KC], kcc_[G::KC];
#pragma unroll
    for (int i = 0; i < G::KC; ++i) { const int cid = tid + i * 512; krow_[i] = cid / (DQK / 8); kcc_[i] = cid % (DQK / 8); }
#define ATT_LOAD(tile) do { const size_t key0 = (size_t)(tile) * 64; \
        _Pragma("unroll") for (int i = 0; i < G::KC; ++i) kreg[i] = *(const u32x4*)(kbase + (key0 + krow_[i]) * kstride + kcc_[i] * 8); \
        _Pragma("unroll") for (int i = 0; i < 2; ++i) { const int cid = tid + i * 512; vreg[i] = *(const u32x4*)(vtbase + (size_t)(cid >> 3) * M + key0 + (cid & 7) * 8); } } while (0)
#define ATT_WRITE(kslot, vslot) do { LAS unsigned char* kb_ = lds + (kslot) * G::KBUF; LAS unsigned char* vb_ = lds + G::VOFF + (vslot) * G::VBUF; \
        _Pragma("unroll") for (int i = 0; i < G::KC; ++i) *(LAS u32x4*)(kb_ + krow_[i] * G::KROW + kcc_[i] * 16) = kreg[i]; \
        _Pragma("unroll") for (int i = 0; i < 2; ++i) { const int cid = tid + i * 512; *(LAS u32x4*)(vb_ + (cid >> 3) * G::VROW + (cid & 7) * 16) = vreg[i]; } } while (0)
#define ATT_PV(vslot) do { const LAS unsigned char* vb = lds + G::VOFF + (vslot) * G::VBUF; \
        _Pragma("unroll") for (int db = 0; db < 4; ++db) _Pragma("unroll") for (int ks = 0; ks < 4; ++ks) { \
            const bf16x8 va = *(const LAS bf16x8*)(vb + (db * 32 + r32) * G::VROW + ks * 32 + hh * 16); \
            O[db] = __builtin_amdgcn_mfma_f32_32x32x16_bf16(va, pf[ks], O[db], 0, 0, 0); } } while (0)
    const bool late = __builtin_amdgcn_readfirstlane(tid >> 6) >= 4;
    bf16x8 pf[4]; bool have_pf = false; int vprev = 0;
#pragma unroll
    for (int i = 0; i < 4; ++i) pf[i] = (bf16x8){0, 0, 0, 0, 0, 0, 0, 0};
    ATT_LOAD(tile_lo); ATT_WRITE(0, 0);
    __syncthreads();
    int vcur = 0;
    for (int it = 0; it < nt; ++it) {
        const int tile = tile_lo + it, buf = it & 1;
        const int vnext = (vcur == 2) ? 0 : vcur + 1;
        if (it + 1 < nt) ATT_LOAD(tile + 1);
        if (late && have_pf) { ATT_PV(vprev); have_pf = false; }
        if (tile >= wlo && tile < whi) {
            const LAS unsigned char* kb = lds + buf * G::KBUF;
            f32x16 S0, S1;
#pragma unroll
            for (int j = 0; j < 16; ++j) { S0[j] = 0.f; S1[j] = 0.f; }
#pragma unroll
            for (int dc = 0; dc < DQK / 16; ++dc) {
                const bf16x8 ka = *(const LAS bf16x8*)(kb + r32 * G::KROW + dc * 32 + hh * 16);
                const bf16x8 kb2 = *(const LAS bf16x8*)(kb + (32 + r32) * G::KROW + dc * 32 + hh * 16);
                S0 = __builtin_amdgcn_mfma_f32_32x32x16_bf16(ka, qf[dc], S0, 0, 0, 0);
                S1 = __builtin_amdgcn_mfma_f32_32x32x16_bf16(kb2, qf[dc], S1, 0, 0, 0);
            }
            if (MODE == 1) {
                const LAS float* rpbL = (const LAS float*)(lds + G::RPB_OFF);
                const int c = a0; int cs = c - 8; cs = cs < 0 ? 0 : (cs > 48 ? 48 : cs);
                const LAS float* rrow = rpbL + (tile + a1) * 31;
                int cb = 4 * hh + 15 - c, vb_ = 4 * hh - cs; asm volatile("" : "+v"(cb), "+v"(vb_));
                float bb0[16], bb1[16];
#pragma unroll
                for (int j = 0; j < 16; ++j) {
                    const int kk = (j & 3) + 8 * (j >> 2);
                    int i0 = kk + cb; i0 = i0 < 0 ? 0 : (i0 > 30 ? 30 : i0); int i1 = kk + 32 + cb; i1 = i1 < 0 ? 0 : (i1 > 30 ? 30 : i1);
                    bb0[j] = rrow[i0]; bb1[j] = rrow[i1];
                }
#pragma unroll
                for (int j = 0; j < 16; ++j) asm volatile("" : "+v"(bb0[j]), "+v"(bb1[j]));
#pragma unroll
                for (int j = 0; j < 16; ++j) {
                    const int kk = (j & 3) + 8 * (j >> 2);
                    S0[j] = ((unsigned)(kk + vb_) < 16u) ? S0[j] + bb0[j] : -INFINITY;
                    S1[j] = ((unsigned)(kk + 32 + vb_) < 16u) ? S1[j] + bb1[j] : -INFINITY;
                }
            }
            if (MODE == 2) {
                const int dbase = tile * 64 - a0;
#pragma unroll
                for (int j = 0; j < 16; ++j) {
                    const int d0 = dbase + crow(j, hh), d1 = d0 + 32;
                    S0[j] = (d0 >= -128 && d0 <= 128) ? S0[j] : -INFINITY;
                    S1[j] = (d1 >= -128 && d1 <= 128) ? S1[j] : -INFINITY;
                }
            }
            float pmax = S0[0];
#pragma unroll
            for (int j = 1; j < 16; ++j) pmax = fmaxf(pmax, S0[j]);
#pragma unroll
            for (int j = 0; j < 16; ++j) pmax = fmaxf(pmax, S1[j]);
            { auto rr = __builtin_amdgcn_permlane32_swap(__float_as_uint(pmax), __float_as_uint(pmax), false, false); pmax = fmaxf(__uint_as_float(rr[0]), __uint_as_float(rr[1])); }
            if (!__all(pmax - m <= 8.0f)) {
                const float mn2 = fmaxf(m, pmax); const float alpha = __builtin_amdgcn_exp2f(m - mn2); m = mn2; l *= alpha;
#pragma unroll
                for (int i = 0; i < 4; ++i)
#pragma unroll
                    for (int j = 0; j < 16; ++j) O[i][j] *= alpha;
            }
            const float mn = m;
            float ps = 0.f;
#pragma unroll
            for (int j = 0; j < 16; ++j) { S0[j] = __builtin_amdgcn_exp2f(S0[j] - mn); S1[j] = __builtin_amdgcn_exp2f(S1[j] - mn); ps += S0[j] + S1[j]; }
            l += ps;
            { u32x4 w;
              w.x = cvt_pk_bf16(S0[0], S0[1]); w.y = cvt_pk_bf16(S0[2], S0[3]); w.z = cvt_pk_bf16(S0[4], S0[5]); w.w = cvt_pk_bf16(S0[6], S0[7]); pf[0] = *(bf16x8*)&w;
              w.x = cvt_pk_bf16(S0[8], S0[9]); w.y = cvt_pk_bf16(S0[10], S0[11]); w.z = cvt_pk_bf16(S0[12], S0[13]); w.w = cvt_pk_bf16(S0[14], S0[15]); pf[1] = *(bf16x8*)&w;
              w.x = cvt_pk_bf16(S1[0], S1[1]); w.y = cvt_pk_bf16(S1[2], S1[3]); w.z = cvt_pk_bf16(S1[4], S1[5]); w.w = cvt_pk_bf16(S1[6], S1[7]); pf[2] = *(bf16x8*)&w;
              w.x = cvt_pk_bf16(S1[8], S1[9]); w.y = cvt_pk_bf16(S1[10], S1[11]); w.z = cvt_pk_bf16(S1[12], S1[13]); w.w = cvt_pk_bf16(S1[14], S1[15]); pf[3] = *(bf16x8*)&w; }
            if (!late) ATT_PV(vcur); else { have_pf = true; vprev = vcur; }
        }
        if (it + 1 < nt) ATT_WRITE(buf ^ 1, vnext);
        vcur = vnext;
        __syncthreads();
    }
    if (late && have_pf) ATT_PV(vprev);
#undef ATT_LOAD
#undef ATT_WRITE
#undef ATT_PV
    { auto rr = __builtin_amdgcn_permlane32_swap(__float_as_uint(l), __float_as_uint(l), false, false); l = __uint_as_float(rr[0]) + __uint_as_float(rr[1]); }
    const float inv = 1.0f / l;
#pragma unroll
    for (int db = 0; db < 4; ++db)
#pragma unroll
        for (int t = 0; t < 2; ++t) {
            const unsigned x0 = cvt_pk_bf16(O[db][8 * t + 0] * inv, O[db][8 * t + 1] * inv), x1 = cvt_pk_bf16(O[db][8 * t + 2] * inv, O[db][8 * t + 3] * inv);
            const unsigned y0 = cvt_pk_bf16(O[db][8 * t + 4] * inv, O[db][8 * t + 5] * inv), y1 = cvt_pk_bf16(O[db][8 * t + 6] * inv, O[db][8 * t + 7] * inv);
            auto r0 = __builtin_amdgcn_permlane32_swap(x0, y0, false, false); auto r1 = __builtin_amdgcn_permlane32_swap(x1, y1, false, false);
            u32x4 w = {r0[0], r1[0], r0[1], r1[1]};
            *(u32x4*)(optr + db * 32 + 16 * t + 8 * hh) = w;
        }
    __syncthreads();
}

__global__ void __launch_bounds__(NTHREADS, 2) fwd_megakernel(Params P) {
    extern __shared__ __attribute__((aligned(16))) unsigned char lds_raw[];
    LAS unsigned char* lds = (LAS unsigned char*)lds_raw;
    cg::grid_group grid = cg::this_grid();
    if (threadIdx.x < 4) ((LAS unsigned*)(lds + LDS_BYTES - 16))[threadIdx.x] = 0u;
    __syncthreads();
    XcdBarrier xbar;
    { KARG(kpb); xbar = xcd_barrier_post((unsigned*)(kpb->ws + WS_BAR), (volatile LAS unsigned*)(lds + LDS_BYTES - 16)); }
#define GRID_SYNC() xcd_barrier(xbar)
    { KARG(kpc); if (kpc->ws == nullptr) grid.sync(); }
#define PHASE_VARS \
    KARG(kp); unsigned char* ws = kp->ws; float* X = kp->out; \
    int tid = threadIdx.x; asm volatile("" : "+v"(tid)); const int lane = tid & 63, wave = __builtin_amdgcn_readfirstlane(tid >> 6); \
    int bid = blockIdx.x; asm volatile("" : "+s"(bid)); const int G = gridDim.x; const int gw = bid * NWAVES + wave, ngw = G * NWAVES; \
    bf16_t* H = (bf16_t*)(ws + WS_H); bf16_t* E = (bf16_t*)(ws + WS_E); bf16_t* PB = (bf16_t*)(ws + WS_PB); \
    float* SS = (float*)(ws + WS_SS); float* ROPE64 = (float*)(ws + WS_ROPE64); float* ROPE128 = (float*)(ws + WS_ROPE128); \
    LAS float* scr = (LAS float*)(lds + wave * 16640); \
    (void)X; (void)H; (void)E; (void)PB; (void)SS; (void)ROPE64; (void)ROPE128; (void)scr; (void)gw; (void)ngw; (void)lane; (void)G

    if (PH(0)) {
        PHASE_VARS;
        _Pragma("unroll 1") for (int rep_ = 0; rep_ < REP_CONV; ++rep_) {
        convert_matrix(kp->in[I_EV_WIN], D, EV_IN, (bf16_t*)(ws + W_EVIN), scr, gw, ngw, lane);
        convert_matrix(kp->in[I_WQB], 512, 1536, (bf16_t*)(ws + W_QB), scr, gw, ngw, lane);
        convert_matrix(kp->in[I_WKVB], 256, 2048, (bf16_t*)(ws + W_KVB), scr, gw, ngw, lane);
        }
        for (int i = bid * NTHREADS + tid; i < 4096 * 32; i += G * NTHREADS) { const int pos = i >> 5, f = i & 31;
            const float inv = exp2f(-(float)(2 * f) / 64.0f * 13.287712379549449f);
            double rev = (double)pos * (double)inv * 0.15915494309189535; rev -= floor(rev);
            ROPE64[i] = __builtin_amdgcn_cosf((float)rev); ROPE64[4096 * 32 + i] = __builtin_amdgcn_sinf((float)rev); }
        for (int i = bid * NTHREADS + tid; i < 4096 * 64; i += G * NTHREADS) { const int pos = i >> 6, f = i & 63;
            const float inv = exp2f(-(float)(2 * f) / 128.0f * 13.287712379549449f);
            double rev = (double)pos * (double)inv * 0.15915494309189535; rev -= floor(rev);
            ROPE128[i] = __builtin_amdgcn_cosf((float)rev); ROPE128[4096 * 64 + i] = __builtin_amdgcn_sinf((float)rev); }
        _Pragma("unroll 1") for (int rp_ = 0; rp_ < REP_PREP; ++rp_) for (int row = gw; row < M; row += ngw) {
            const float* xr = row < 8192 ? kp->in[I_XP] + (size_t)row * D : kp->in[I_XS] + (size_t)(row - 8192) * D;
            norm_row(xr, kp->in[I_ATTN_NORM], H + (size_t)row * D, nullptr, lane);
        }
        for (int i = bid * NTHREADS + tid; i < 5 * M; i += G * NTHREADS) SS[i] = 0.f;
    }
    GRID_SYNC();

    if (PH(1)) { PHASE_VARS; pg8::EpiBf16<0> Ep{(bf16_t*)(ws + B_Z), EV_INP, nullptr, nullptr}; pg8::run_gemm(lds, H, (const bf16_t*)(ws + W_EVIN), EV_INP, D, Ep); }
    GRID_SYNC();

    if (PH(2)) {
        PHASE_VARS;
        const bf16_t* Z = (const bf16_t*)(ws + B_Z);
        bf16_t* QN = (bf16_t*)(ws + B_QN); bf16_t* KVN = (bf16_t*)(ws + B_KVN); bf16_t* KR = (bf16_t*)(ws + B_KR);
        bf16_t* NQ = (bf16_t*)(ws + B_NQ); bf16_t* NK = (bf16_t*)(ws + B_NK); bf16_t* NVT = (bf16_t*)(ws + B_NVT);
        const float CNA = 0.08838834764831845f * LOG2E;
        _Pragma("unroll 1") for (int rp_ = 0; rp_ < REP_PREP; ++rp_) for (int tok = gw; tok < M; tok += ngw) {
            const bf16_t* z = Z + (size_t)tok * EV_INP; const int pos = tok_pos(tok);
            { const u32x4 w = *(const u32x4*)(z + 8 * lane);
              float v[8] = {bflo(w.x), bfhi(w.x), bflo(w.y), bfhi(w.y), bflo(w.z), bfhi(w.z), bflo(w.w), bfhi(w.w)}; float s = 0.f;
#pragma unroll
              for (int j = 0; j < 8; ++j) s += v[j] * v[j];
              const float ri = 1.0f / sqrtf(wave_sum(s) * (1.f / 512.f) + EPS); const float* g = kp->in[I_QA_NORM] + 8 * lane;
              u32x4 o; o.x = cvt_pk_bf16(v[0] * ri * g[0], v[1] * ri * g[1]); o.y = cvt_pk_bf16(v[2] * ri * g[2], v[3] * ri * g[3]); o.z = cvt_pk_bf16(v[4] * ri * g[4], v[5] * ri * g[5]); o.w = cvt_pk_bf16(v[6] * ri * g[6], v[7] * ri * g[7]);
              *(u32x4*)(QN + (size_t)tok * 512 + 8 * lane) = o; }
            { const u32x2 w = *(const u32x2*)(z + 512 + 4 * lane);
              float v[4] = {bflo(w.x), bfhi(w.x), bflo(w.y), bfhi(w.y)}; const float s = (v[0] * v[0] + v[1] * v[1]) + (v[2] * v[2] + v[3] * v[3]);
              const float ri = 1.0f / sqrtf(wave_sum(s) * (1.f / 256.f) + EPS); const float* g = kp->in[I_KVA_NORM] + 4 * lane;
              u32x2 o; o.x = cvt_pk_bf16(v[0] * ri * g[0], v[1] * ri * g[1]); o.y = cvt_pk_bf16(v[2] * ri * g[2], v[3] * ri * g[3]);
              *(u32x2*)(KVN + (size_t)tok * 256 + 4 * lane) = o; }
            { const float v = bf2f(z[768 + lane]); const float ri = 1.0f / sqrtf(wave_sum(v * v) * (1.f / 64.f) + EPS);
              const float y = v * ri * kp->in[I_KROPE_NORM][lane]; const float yp = __shfl_xor(y, 32);
              const float c = ROPE64[pos * 32 + (lane & 31)], s = ROPE64[4096 * 32 + pos * 32 + (lane & 31)];
              const float o = lane < 32 ? y * c - yp * s : y * c + yp * s;
              KR[(size_t)tok * 64 + lane] = f2bf(o); }
#pragma unroll
            for (int p = 0; p < 2; ++p) {
                const int d0 = 8 * (lane & 15);
                { const u32x4 w = *(const u32x4*)(z + 832 + p * 512 + 8 * lane);
                  float v[8] = {bflo(w.x), bfhi(w.x), bflo(w.y), bfhi(w.y), bflo(w.z), bfhi(w.z), bflo(w.w), bfhi(w.w)}; float s = 0.f;
#pragma unroll
                  for (int j = 0; j < 8; ++j) s += v[j] * v[j];
                  const float ri = CNA / sqrtf(group_sum<16>(s) * (1.f / 128.f) + EPS); const float* g = kp->in[I_NAQ_NORM] + d0;
                  u32x4 o; o.x = cvt_pk_bf16(v[0] * ri * g[0], v[1] * ri * g[1]); o.y = cvt_pk_bf16(v[2] * ri * g[2], v[3] * ri * g[3]); o.z = cvt_pk_bf16(v[4] * ri * g[4], v[5] * ri * g[5]); o.w = cvt_pk_bf16(v[6] * ri * g[6], v[7] * ri * g[7]);
                  *(u32x4*)(NQ + (size_t)tok * 1024 + p * 512 + 8 * lane) = o; }
                { const u32x4 w = *(const u32x4*)(z + 1856 + p * 512 + 8 * lane);
                  float v[8] = {bflo(w.x), bfhi(w.x), bflo(w.y), bfhi(w.y), bflo(w.z), bfhi(w.z), bflo(w.w), bfhi(w.w)}; float s = 0.f;
#pragma unroll
                  for (int j = 0; j < 8; ++j) s += v[j] * v[j];
                  const float ri = 1.0f / sqrtf(group_sum<16>(s) * (1.f / 128.f) + EPS); const float* g = kp->in[I_NAK_NORM] + d0;
                  u32x4 o; o.x = cvt_pk_bf16(v[0] * ri * g[0], v[1] * ri * g[1]); o.y = cvt_pk_bf16(v[2] * ri * g[2], v[3] * ri * g[3]); o.z = cvt_pk_bf16(v[4] * ri * g[4], v[5] * ri * g[5]); o.w = cvt_pk_bf16(v[6] * ri * g[6], v[7] * ri * g[7]);
                  *(u32x4*)(NK + (size_t)tok * 1024 + p * 512 + 8 * lane) = o; }
            }
        }
        __syncthreads();
        _Pragma("unroll 1") for (int rp_ = 0; rp_ < REP_PREP; ++rp_) for (int it = bid; it < 256 * 8; it += G) { const int tt = it >> 3, h = it & 7;
            vt_item(lds, Z + (size_t)(tt * 64) * EV_INP + 2880 + h * 128, EV_INP, NVT + (size_t)(h * 128) * M, tt * 64); }
    }
    GRID_SYNC();

    if (PH(3)) { PHASE_VARS; pg8::EpiBf16<0> Ep{(bf16_t*)(ws + B_Q1), 1536, nullptr, nullptr}; pg8::run_gemm(lds, (const bf16_t*)(ws + B_QN), (const bf16_t*)(ws + W_QB), 1536, 512, Ep); }
    if (PH(3)) { PHASE_VARS; pg8::EpiBf16<0> Ep{(bf16_t*)(ws + B_KV1), 2048, nullptr, nullptr}; pg8::run_gemm(lds, (const bf16_t*)(ws + B_KVN), (const bf16_t*)(ws + W_KVB), 2048, 256, Ep); }
    GRID_SYNC();

    if (PH(4)) {
        PHASE_VARS;
        const bf16_t* Q1 = (const bf16_t*)(ws + B_Q1); const bf16_t* KV1 = (const bf16_t*)(ws + B_KV1); const bf16_t* KR = (const bf16_t*)(ws + B_KR);
        bf16_t* QM = (bf16_t*)(ws + HE_QM); bf16_t* KM = (bf16_t*)(ws + HE_KM); bf16_t* VTM = (bf16_t*)(ws + HE_VTM);
        const float CM = 0.07216878364870323f * LOG2E;
        const int hq = lane >> 3, sl = lane & 7;
        float gqn[16], gkn[16], gqr[8];
#pragma unroll
        for (int j = 0; j < 16; ++j) { gqn[j] = kp->in[I_QNOPE_NORM][sl * 16 + j]; gkn[j] = kp->in[I_KNOPE_NORM][sl * 16 + j]; }
#pragma unroll
        for (int j = 0; j < 8; ++j) gqr[j] = kp->in[I_QROPE_NORM][sl * 8 + j];
        _Pragma("unroll 1") for (int rp_ = 0; rp_ < REP_PREP; ++rp_) for (int tok = gw; tok < M; tok += ngw) {
            const int pos = tok_pos(tok);
            const bf16_t* q = Q1 + (size_t)tok * 1536 + hq * 192; bf16_t* qo = QM + (size_t)tok * 1536 + hq * 192;
            const bf16_t* k = KV1 + (size_t)tok * 2048 + hq * 256; bf16_t* ko = KM + (size_t)tok * 1536 + hq * 192;
            const u32x4 qa = *(const u32x4*)(q + sl * 16), qb = *(const u32x4*)(q + sl * 16 + 8), qr = *(const u32x4*)(q + 128 + sl * 8);
            const u32x4 ka = *(const u32x4*)(k + sl * 16), kb = *(const u32x4*)(k + sl * 16 + 8), krv = *(const u32x4*)(KR + (size_t)tok * 64 + sl * 8);
            const f32x4 c0 = *(const f32x4*)(ROPE64 + pos * 32 + (sl & 3) * 8), c1 = *(const f32x4*)(ROPE64 + pos * 32 + (sl & 3) * 8 + 4);
            const f32x4 s0 = *(const f32x4*)(ROPE64 + 4096 * 32 + pos * 32 + (sl & 3) * 8), s1 = *(const f32x4*)(ROPE64 + 4096 * 32 + pos * 32 + (sl & 3) * 8 + 4);
            { float v[16] = {bflo(qa.x), bfhi(qa.x), bflo(qa.y), bfhi(qa.y), bflo(qa.z), bfhi(qa.z), bflo(qa.w), bfhi(qa.w), bflo(qb.x), bfhi(qb.x), bflo(qb.y), bfhi(qb.y), bflo(qb.z), bfhi(qb.z), bflo(qb.w), bfhi(qb.w)};
              float ss = 0.f;
#pragma unroll
              for (int j = 0; j < 16; ++j) ss += v[j] * v[j];
              const float ri = CM / sqrtf(group_sum<8>(ss) * (1.f / 128.f) + EPS);
              u32x4 o0, o1;
              o0.x = cvt_pk_bf16(v[0] * ri * gqn[0], v[1] * ri * gqn[1]); o0.y = cvt_pk_bf16(v[2] * ri * gqn[2], v[3] * ri * gqn[3]); o0.z = cvt_pk_bf16(v[4] * ri * gqn[4], v[5] * ri * gqn[5]); o0.w = cvt_pk_bf16(v[6] * ri * gqn[6], v[7] * ri * gqn[7]);
              o1.x = cvt_pk_bf16(v[8] * ri * gqn[8], v[9] * ri * gqn[9]); o1.y = cvt_pk_bf16(v[10] * ri * gqn[10], v[11] * ri * gqn[11]); o1.z = cvt_pk_bf16(v[12] * ri * gqn[12], v[13] * ri * gqn[13]); o1.w = cvt_pk_bf16(v[14] * ri * gqn[14], v[15] * ri * gqn[15]);
              *(u32x4*)(qo + sl * 16) = o0; *(u32x4*)(qo + sl * 16 + 8) = o1; }
            { float v[8] = {bflo(qr.x), bfhi(qr.x), bflo(qr.y), bfhi(qr.y), bflo(qr.z), bfhi(qr.z), bflo(qr.w), bfhi(qr.w)};
              const float cc[8] = {c0[0], c0[1], c0[2], c0[3], c1[0], c1[1], c1[2], c1[3]}, sn[8] = {s0[0], s0[1], s0[2], s0[3], s1[0], s1[1], s1[2], s1[3]};
              float ss = 0.f;
#pragma unroll
              for (int j = 0; j < 8; ++j) ss += v[j] * v[j];
              const float ri = 1.0f / sqrtf(group_sum<8>(ss) * (1.f / 64.f) + EPS);
              float o[8];
#pragma unroll
              for (int j = 0; j < 8; ++j) { const float y = v[j] * ri * gqr[j]; const float yp = __shfl_xor(y, 4); o[j] = (sl < 4 ? y * cc[j] - yp * sn[j] : y * cc[j] + yp * sn[j]) * CM; }
              u32x4 w; w.x = cvt_pk_bf16(o[0], o[1]); w.y = cvt_pk_bf16(o[2], o[3]); w.z = cvt_pk_bf16(o[4], o[5]); w.w = cvt_pk_bf16(o[6], o[7]);
              *(u32x4*)(qo + 128 + sl * 8) = w; }
            { float v[16] = {bflo(ka.x), bfhi(ka.x), bflo(ka.y), bfhi(ka.y), bflo(ka.z), bfhi(ka.z), bflo(ka.w), bfhi(ka.w), bflo(kb.x), bfhi(kb.x), bflo(kb.y), bfhi(kb.y), bflo(kb.z), bfhi(kb.z), bflo(kb.w), bfhi(kb.w)};
              float ss = 0.f;
#pragma unroll
              for (int j = 0; j < 16; ++j) ss += v[j] * v[j];
              const float ri = 1.0f / sqrtf(group_sum<8>(ss) * (1.f / 128.f) + EPS);
              u32x4 o0, o1;
              o0.x = cvt_pk_bf16(v[0] * ri * gkn[0], v[1] * ri * gkn[1]); o0.y = cvt_pk_bf16(v[2] * ri * gkn[2], v[3] * ri * gkn[3]); o0.z = cvt_pk_bf16(v[4] * ri * gkn[4], v[5] * ri * gkn[5]); o0.w = cvt_pk_bf16(v[6] * ri * gkn[6], v[7] * ri * gkn[7]);
              o1.x = cvt_pk_bf16(v[8] * ri * gkn[8], v[9] * ri * gkn[9]); o1.y = cvt_pk_bf16(v[10] * ri * gkn[10], v[11] * ri * gkn[11]); o1.z = cvt_pk_bf16(v[12] * ri * gkn[12], v[13] * ri * gkn[13]); o1.w = cvt_pk_bf16(v[14] * ri * gkn[14], v[15] * ri * gkn[15]);
              *(u32x4*)(ko + sl * 16) = o0; *(u32x4*)(ko + sl * 16 + 8) = o1; }
            *(u32x4*)(ko + 128 + sl * 8) = krv;
        }
        __syncthreads();
        _Pragma("unroll 1") for (int rp_ = 0; rp_ < REP_PREP; ++rp_) for (int it = bid; it < 256 * 8; it += G) { const int tt = it >> 3, h = it & 7;
            vt_item(lds, KV1 + (size_t)(tt * 64) * 2048 + h * 256 + 128, 2048, VTM + (size_t)(h * 128) * M, tt * 64); }
    }
    GRID_SYNC();

    if (PH(5)) {
        PHASE_VARS;
        const bf16_t* QM = (const bf16_t*)(ws + HE_QM); const bf16_t* KM = (const bf16_t*)(ws + HE_KM); const bf16_t* VTM = (const bf16_t*)(ws + HE_VTM);
        const bf16_t* NQ = (const bf16_t*)(ws + B_NQ); const bf16_t* NK = (const bf16_t*)(ws + B_NK); const bf16_t* NVT = (const bf16_t*)(ws + B_NVT);
        bf16_t* OC = (bf16_t*)(ws + B_OCAT0);
        const int cslot = (G == 256) ? ((bid >> 3) % 5) : 0; int aunit = 0;
#define A1_CONV() do { if (aunit == cslot) { __syncthreads(); convert_list<0>(kp, ws, scr, gw, ngw, lane); __syncthreads(); } ++aunit; } while (0)
        _Pragma("unroll 1") for (int rep_ = 0; rep_ < REP_MLA; ++rep_)
        for (int u = bid; u < 512; u += G) {
            A1_CONV();
            int seqbase, T, h, qb;
            int uu = u; if (G == 256) { const int b = u & 255, x = b & 7, j = b >> 3; uu = (u < 256) ? (x * 2 + (j >> 4)) * 16 + (j & 15) : 256 + (x * 4 + (j >> 3)) * 8 + (j & 7); }
            if (uu < 256) { const int s = uu >> 7; seqbase = s * 4096; T = 4096; h = (uu >> 4) & 7; qb = uu & 15; }
            else { const int v = uu - 256; const int s = v >> 6; seqbase = 8192 + s * 2048; T = 2048; h = (v >> 3) & 7; qb = v & 7; }
            const int tq = seqbase + qb * 256 + wave * 32 + (lane & 31);
            const int t0 = seqbase >> 6, t1 = (seqbase + T) >> 6;
            attn_unit<192, 0>(lds, QM + (size_t)tq * 1536 + h * 192, KM + h * 192, 1536, VTM + (size_t)(h * 128) * M, t0, t1, t0, t1, 0, 0, -1e30f, 0.f, OC + (size_t)tq * 2048 + h * 128);
        }
        _Pragma("unroll 1") for (int rep_ = 0; rep_ < REP_NA; ++rep_)
        for (int u = bid; u < 512; u += G) {
            A1_CONV();
            int seqbase, rows, h, rg;
            int uu = u; if (G == 256) { const int b = u & 255, x = b & 7, j = b >> 3; uu = (u < 256) ? (x * 2 + (j >> 4)) * 16 + (j & 15) : 256 + (x * 4 + (j >> 3)) * 8 + (j & 7); }
            if (uu < 256) { const int s = uu >> 7; seqbase = s * 4096; rows = 64; h = (uu >> 4) & 7; rg = uu & 15; }
            else { const int v = uu - 256; const int s = v >> 6; seqbase = 8192 + s * 2048; rows = 32; h = (v >> 3) & 7; rg = v & 7; }
            { LAS float* rpbL = (LAS float*)(lds + AG<128>::RPB_OFF); for (int i = tid; i < 465; i += NTHREADS) rpbL[i] = kp->in[I_RPB][h * 465 + i] * LOG2E; }
            const int r = rg * 4 + (wave >> 1), c = (wave & 1) * 32 + (lane & 31);
            const int tq = seqbase + r * 64 + c;
            const int st0 = seqbase >> 6;
            int rs_lo = rg * 4 - 4; rs_lo = rs_lo < 0 ? 0 : (rs_lo > rows - 8 ? rows - 8 : rs_lo);
            int rs_hi = rg * 4 + 3 - 4; rs_hi = rs_hi < 0 ? 0 : (rs_hi > rows - 8 ? rows - 8 : rs_hi);
            int rs = r - 4; rs = rs < 0 ? 0 : (rs > rows - 8 ? rows - 8 : rs);
            attn_unit<128, 1>(lds, NQ + (size_t)tq * 1024 + h * 128, NK + h * 128, 1024, NVT + (size_t)(h * 128) * M, st0 + rs_lo, st0 + rs_hi + 8, st0 + rs, st0 + rs + 8, c, 7 - r - st0, -1e30f, 0.f,
                              OC + (size_t)tq * 2048 + 1024 + h * 128);
        }
        if (aunit <= cslot) { aunit = cslot; A1_CONV(); }
#undef A1_CONV
    }
    GRID_SYNC();

    if (PH(6)) { PHASE_VARS; pg8::EpiResidB Ep{nullptr, kp->in[I_XP], kp->in[I_XS], H, SS + 0 * M, nullptr}; pg8::run_gemm(lds, (const bf16_t*)(ws + B_OCAT0), (const bf16_t*)(ws + W_EVOUT), D, D, Ep); }
    if (PH(6)) { PHASE_VARS; pg8::EpiBf16<0> Ep{E, D, nullptr, SS + 3 * M}; pg8::run_gemm(lds, PB, (const bf16_t*)(ws + W_PROJ), D, 256, Ep); }
    GRID_SYNC();

    if (PH(9)) { PHASE_VARS; pg8::EpiBf16<1> Ep{(bf16_t*)(ws + B_ACT), DFF, nullptr, nullptr};
        pg8::run_gemm(lds, H, (const bf16_t*)(ws + W_UP), DFF, D, Ep); }
    GRID_SYNC();
    if (PH(10)) { PHASE_VARS; pg8::EpiResidB Ep{H, nullptr, nullptr, (bf16_t*)X, nullptr, SS + 0 * M};
        pg8::run_gemm(lds, (const bf16_t*)(ws + B_ACT), (const bf16_t*)(ws + W_DOWN), D, DFF, Ep); }
    GRID_SYNC();
    if (PH(11)) { PHASE_VARS; pg8::EpiGateB Ep{(const bf16_t*)X, E, SS + 3 * M, kp->in[I_PLE_NORM], H, SS + 2 * M, nullptr};
        pg8::run_gemm(lds, (const bf16_t*)X, (const bf16_t*)(ws + W_GATE), D, D, Ep); }
    GRID_SYNC();

    if (PH(7)) {
            { PHASE_VARS; pg8::EpiBf16<0> Ep{(bf16_t*)(ws + B_Z), OD_IN, SS + 2 * M, nullptr}; pg8::run_gemm(lds, H, (const bf16_t*)(ws + W_ODIN), OD_IN, D, Ep); }
            GRID_SYNC();
            {
                PHASE_VARS;
                const bf16_t* Z3 = (const bf16_t*)(ws + B_Z); bf16_t* SQ = (bf16_t*)(ws + B_SQ); bf16_t* SK = (bf16_t*)(ws + B_SK); bf16_t* SVT = (bf16_t*)(ws + B_SVT);
                const float CS = 0.08838834764831845f * LOG2E;
                const int hs = lane >> 3, j8 = 8 * (lane & 7);
                float gq[16], gk[16];
#pragma unroll
                for (int j = 0; j < 8; ++j) { gq[j] = kp->in[I_SWAQ_NORM][j8 + j]; gq[8 + j] = kp->in[I_SWAQ_NORM][64 + j8 + j]; gk[j] = kp->in[I_SWAK_NORM][j8 + j]; gk[8 + j] = kp->in[I_SWAK_NORM][64 + j8 + j]; }
                _Pragma("unroll 1") for (int rp_ = 0; rp_ < REP_PREP; ++rp_) for (int tok = gw; tok < M; tok += ngw) {
                    const int pos = tok_pos(tok);
                    const f32x4 c0 = *(const f32x4*)(ROPE128 + pos * 64 + j8), c1 = *(const f32x4*)(ROPE128 + pos * 64 + j8 + 4);
                    const f32x4 s0 = *(const f32x4*)(ROPE128 + 4096 * 64 + pos * 64 + j8), s1 = *(const f32x4*)(ROPE128 + 4096 * 64 + pos * 64 + j8 + 4);
                    const float cc[8] = {c0[0], c0[1], c0[2], c0[3], c1[0], c1[1], c1[2], c1[3]}, sn[8] = {s0[0], s0[1], s0[2], s0[3], s1[0], s1[1], s1[2], s1[3]};
                    const bf16_t* z = Z3 + (size_t)tok * OD_IN;
#pragma unroll
                    for (int p = 0; p < 3; ++p) {
                        const int head = 8 * p + hs; const bool act = head < 20; const int hc = act ? head : 19;
                        const bf16_t* src = z + hc * 128;
                        const u32x4 w1 = *(const u32x4*)(src + j8), w2 = *(const u32x4*)(src + 64 + j8);
                        const float a[8] = {bflo(w1.x), bfhi(w1.x), bflo(w1.y), bfhi(w1.y), bflo(w1.z), bfhi(w1.z), bflo(w1.w), bfhi(w1.w)};
                        const float b[8] = {bflo(w2.x), bfhi(w2.x), bflo(w2.y), bfhi(w2.y), bflo(w2.z), bfhi(w2.z), bflo(w2.w), bfhi(w2.w)};
                        float ss = 0.f;
#pragma unroll
                        for (int j = 0; j < 8; ++j) ss += a[j] * a[j] + b[j] * b[j];
                        const bool isq = hc < 16;
                        const float ri = (isq ? CS : 1.0f) / sqrtf(group_sum<8>(ss) * (1.f / 128.f) + EPS);
                        float o1[8], o2[8];
#pragma unroll
                        for (int j = 0; j < 8; ++j) { const float y1 = a[j] * ri * (isq ? gq[j] : gk[j]), y2 = b[j] * ri * (isq ? gq[8 + j] : gk[8 + j]); o1[j] = y1 * cc[j] - y2 * sn[j]; o2[j] = y2 * cc[j] + y1 * sn[j]; }
                        u32x4 v1, v2;
                        v1.x = cvt_pk_bf16(o1[0], o1[1]); v1.y = cvt_pk_bf16(o1[2], o1[3]); v1.z = cvt_pk_bf16(o1[4], o1[5]); v1.w = cvt_pk_bf16(o1[6], o1[7]);
                        v2.x = cvt_pk_bf16(o2[0], o2[1]); v2.y = cvt_pk_bf16(o2[2], o2[3]); v2.z = cvt_pk_bf16(o2[4], o2[5]); v2.w = cvt_pk_bf16(o2[6], o2[7]);
                        bf16_t* dst = isq ? SQ + (size_t)tok * 2048 + hc * 128 : SK + (size_t)tok * 512 + (hc - 16) * 128;
                        if (act) { *(u32x4*)(dst + j8) = v1; *(u32x4*)(dst + 64 + j8) = v2; }
                    }
                }
                __syncthreads();
                _Pragma("unroll 1") for (int rp_ = 0; rp_ < REP_PREP; ++rp_) for (int it = bid; it < 256 * 4; it += G) { const int tt = it >> 2, h = it & 3;
                    vt_item(lds, Z3 + (size_t)(tt * 64) * OD_IN + 2560 + h * 128, OD_IN, SVT + (size_t)(h * 128) * M, tt * 64); }
            }
            GRID_SYNC();
            {
                PHASE_VARS;
                const bf16_t* SQ = (const bf16_t*)(ws + B_SQ); const bf16_t* SK = (const bf16_t*)(ws + B_SK); const bf16_t* SVT = (const bf16_t*)(ws + B_SVT);
                bf16_t* OC = (bf16_t*)(ws + B_OCAT1);
                const int cslot = (G == 256) ? ((bid >> 3) % 5) : 0; int aunit = 0;
#define A2_CONV() do { if (aunit == cslot) { __syncthreads(); convert_list<1>(kp, ws, scr, gw, ngw, lane); __syncthreads(); } ++aunit; } while (0)
                _Pragma("unroll 1") for (int rep_ = 0; rep_ < REP_SWA; ++rep_)
                for (int u = bid; u < 1024; u += G) {
                    A2_CONV();
                    int kvh = u & 3, ch = u >> 2;
                    if (G == 256) { const int b = u & 255, x = b & 7, j = b >> 3; kvh = u >> 8; ch = 32 * x + j; }
                    const int tok0 = ch * 64;
                    const int seqbase = tok0 < 8192 ? (tok0 & ~4095) : (tok0 & ~2047); const int T = tok0 < 8192 ? 4096 : 2048;
                    const int head = kvh * 4 + (wave >> 1);
                    const int tq = tok0 + (wave & 1) * 32 + (lane & 31);
                    int tlo = ch - 2, thi = ch + 3; const int s0 = seqbase >> 6, s1 = (seqbase + T) >> 6; tlo = tlo < s0 ? s0 : tlo; thi = thi > s1 ? s1 : thi;
                    const float sink = kp->in[I_SINKS][head] * LOG2E;
                    attn_unit<128, 2>(lds, SQ + (size_t)tq * 2048 + head * 128, SK + kvh * 128, 512, SVT + (size_t)(kvh * 128) * M, tlo, thi, tlo, thi, tq, 0, sink, lane < 32 ? 1.f : 0.f,
                                      OC + (size_t)tq * 2048 + head * 128);
                }
                if (aunit <= cslot) { aunit = cslot; A2_CONV(); }
#undef A2_CONV
            }
            GRID_SYNC();
            { PHASE_VARS; pg8::EpiResidB Ep{H, nullptr, nullptr, (bf16_t*)X, SS + 1 * M, nullptr}; pg8::run_gemm(lds, (const bf16_t*)(ws + B_OCAT1), (const bf16_t*)(ws + W_ODOUT), D, D, Ep); }
            { PHASE_VARS; pg8::EpiBf16<0> Ep{E, D, nullptr, SS + 4 * M}; pg8::run_gemm(lds, (const bf16_t*)(ws + WS_PB1), (const bf16_t*)(ws + W_PROJ), D, 256, Ep); }
            GRID_SYNC();
    }
    if (PH(9)) { PHASE_VARS; pg8::EpiBf16<1> Ep{(bf16_t*)(ws + B_ACT), DFF, nullptr, nullptr}; pg8::run_gemm(lds, (const bf16_t*)X, (const bf16_t*)(ws + W_UP), DFF, D, Ep); }
    GRID_SYNC();
    if (PH(10)) { PHASE_VARS; pg8::EpiResidB Ep{(const bf16_t*)X, nullptr, nullptr, H, nullptr, SS + 1 * M}; pg8::run_gemm(lds, (const bf16_t*)(ws + B_ACT), (const bf16_t*)(ws + W_DOWN), D, DFF, Ep); }
    GRID_SYNC();
    if (PH(11)) { PHASE_VARS; pg8::EpiGateF32 Ep{H, E, SS + 4 * M, kp->in[I_PLE_NORM] + D, X}; pg8::run_gemm(lds, H, (const bf16_t*)(ws + W_GATE1), D, D, Ep); }
}

extern "C" void kernel_launch(void* const* d_in, const int* in_sizes, int n_in, void* d_out, int out_size, void* d_ws, size_t ws_size, hipStream_t stream) {
    static int grid_blocks = 0;
    if (!grid_blocks) {
        int dev = 0, cus = 0, per_cu = 0;
        hipGetDevice(&dev);
        hipDeviceGetAttribute(&cus, hipDeviceAttributeMultiprocessorCount, dev);
        hipFuncSetAttribute((const void*)fwd_megakernel, hipFuncAttributeMaxDynamicSharedMemorySize, LDS_BYTES);
        hipOccupancyMaxActiveBlocksPerMultiprocessor(&per_cu, (const void*)fwd_megakernel, NTHREADS, LDS_BYTES);
        if (per_cu < 1) per_cu = 1;
        grid_blocks = cus * per_cu;
        if (ws_size < WS_END) fprintf(stderr, "kernel_launch: workspace too small: %zu < %zu\n", ws_size, (size_t)WS_END);
    }
    Params p{};
    for (int i = 0; i < N_IN; ++i) p.in[i] = (const float*)d_in[i];
    p.out = (float*)d_out; p.ws = (unsigned char*)d_ws;
    (void)hipMemsetAsync((char*)d_ws + WS_BAR, 0, XCD_BAR_WORDS * sizeof(unsigned), stream);
    void* args[] = {&p};
    hipError_t e = hipLaunchCooperativeKernel((const void*)fwd_megakernel, dim3(grid_blocks), dim3(NTHREADS), args, LDS_BYTES, stream);
    if (e != hipSuccess) fprintf(stderr, "cooperative launch failed: %s (grid %d)\n", hipGetErrorString(e), grid_blocks);
}
```
